# Optimizing an MI355X kernel written in HIP

```python
import jax, jax.numpy as jnp
from jax import lax
import numpy as np

D_MODEL = 1024
BATCH = 2
SEQ = 8192
DEPTH = 2

GRID_W = 64
CTX_LEN = 256
EXPAND = 2
D_INNER = EXPAND * D_MODEL
HG_HEAD_DIM = 128
HG_HEADS = D_INNER // HG_HEAD_DIM
HG_STREAMS = 5
FT_GROUPS = 8
FT_GROUP_DIM = D_INNER // FT_GROUPS
CHUNK = 64
N_MIXERS = 2
N_HGRN = (DEPTH + 1) // 2
N_FOURIER = DEPTH // 2
EPS = 1e-6

kernel_name = "hgrn2_fnet_interleaved_prefix_dit"


def rms_norm(x, g):
    xf = x.astype(jnp.float32)
    var = jnp.mean(xf * xf, axis=-1, keepdims=True)
    return (xf * lax.rsqrt(var + EPS)).astype(x.dtype) * g


def adaln(cvec, w, b):
    m = jax.nn.silu(cvec) @ w + b
    return jnp.split(m, 3, axis=-1)


def chunk_scan(q, k, v, g, s0):
    B, H, N, Dk = q.shape
    Dv = v.shape[-1]
    nc = N // CHUNK

    def to_chunks(a):
        a = a.astype(jnp.float32).reshape(B, H, nc, CHUNK, a.shape[-1])
        return jnp.moveaxis(a, 2, 0)

    causal = jnp.tril(jnp.ones((CHUNK, CHUNK), dtype=bool))[:, :, None]

    def step(S, inp):
        qc, kc, vc, gc = inp
        b = jnp.cumsum(gc, axis=-2)
        diff = b[..., :, None, :] - b[..., None, :, :]
        decay = jnp.exp(jnp.where(causal, diff, -jnp.inf))
        scores = jnp.einsum('bhtc,bhtsc,bhsc->bhts', qc, decay, kc)
        o = (jnp.einsum('bhts,bhsv->bhtv', scores, vc)
             + jnp.einsum('bhtc,bhcv->bhtv', qc * jnp.exp(b), S))
        b_last = b[..., -1:, :]
        S_new = (jnp.exp(b_last)[..., 0, :, None] * S
                 + jnp.einsum('bhsc,bhsv->bhcv', kc * jnp.exp(b_last - b), vc))
        return S_new, o

    S_fin, o = lax.scan(step, s0, (to_chunks(q), to_chunks(k), to_chunks(v), to_chunks(g)))
    o = jnp.moveaxis(o, 0, 2).reshape(B, H, N, Dv)
    return o, S_fin


def hgrn_lower_bound(logits, j):
    p = jax.nn.softmax(logits.astype(jnp.float32), axis=0)
    return jnp.cumsum(p, axis=0)[j]


def hgrn_project(h, w_in, lb):
    B, N, _ = h.shape
    p = (h @ w_in).reshape(B, N, HG_STREAMS, HG_HEADS, HG_HEAD_DIM)
    p = jnp.transpose(p, (2, 0, 3, 1, 4))
    q = jax.nn.silu(p[0])
    lbh = lb.reshape(2, 1, HG_HEADS, 1, HG_HEAD_DIM)
    f = lbh + (1.0 - lbh) * jax.nn.sigmoid(p[1:3].astype(jnp.float32))
    return q, 1.0 - f, jnp.log(f), p[3], p[4]


def hgrn_readout(o, z, norm_g, w_out):
    y = rms_norm(o, norm_g).astype(z.dtype) * jax.nn.silu(z)
    B, H, N, d = y.shape
    return jnp.transpose(y, (0, 2, 1, 3)).reshape(B, N, H * d) @ w_out


def hgrn_mixer(h_ctx, h_lat, w_in, lb, norm_g, w_out, ctx_out):
    qc, kc, gc, vc, zc = hgrn_project(h_ctx, w_in, lb)
    ql, kl, gl, vl, zl = hgrn_project(h_lat, w_in, lb)
    B = h_lat.shape[0]
    s0 = jnp.zeros((B, HG_HEADS, HG_HEAD_DIM, HG_HEAD_DIM), jnp.float32)
    flip = lambda a: jnp.flip(a, axis=2)
    o_cf, s_cf = chunk_scan(qc, kc[0], vc, gc[0], s0)
    o_cb, s_cb = chunk_scan(flip(qc), flip(kc[1]), flip(vc), flip(gc[1]), s0)
    o_lf, _ = chunk_scan(ql, kl[0], vl, gl[0], s_cf)
    o_lb, _ = chunk_scan(flip(ql), flip(kl[1]), flip(vl), flip(gl[1]), s_cb)
    y_lat = hgrn_readout(o_lf + flip(o_lb), zl, norm_g, w_out)
    y_ctx = hgrn_readout(o_cf + flip(o_cb), zc, norm_g, w_out) if ctx_out else None
    return y_lat, y_ctx


def fourier_mixer(h, w_in, w_out):
    B, N, _ = h.shape
    u, z = jnp.split(h @ w_in, 2, axis=-1)
    ug = u.astype(jnp.float32).reshape(B, N, FT_GROUPS, FT_GROUP_DIM)
    y = jnp.fft.fft2(ug, axes=(1, 3), norm='ortho').real.reshape(B, N, D_INNER)
    return (y.astype(h.dtype) * jax.nn.silu(z)) @ w_out


def setup_inputs(seed: int = 0) -> dict:
    key = jax.random.key(seed)
    ks = jax.random.split(key, 14)
    D, E = D_MODEL, D_INNER
    nrm = jax.random.normal
    return {
        'x': nrm(ks[0], (BATCH, SEQ, D), jnp.float32),
        'c': nrm(ks[1], (BATCH, D), jnp.float32),
        'ctx': nrm(ks[2], (BATCH, CTX_LEN, D), jnp.float32),
        'c_ctx': nrm(ks[3], (D,), jnp.float32),
        'ada_w': nrm(ks[4], (DEPTH, D, 3 * D), jnp.float32) * (0.5 * D ** -0.5),
        'ada_b': nrm(ks[5], (DEPTH, 3 * D), jnp.float32) * 0.01,
        'norm_g': 1.0 + 0.05 * nrm(ks[6], (DEPTH, D), jnp.float32),
        'hg_w_in': nrm(ks[7], (N_HGRN, D, HG_STREAMS * E), jnp.float32) * D ** -0.5,
        'hg_lb_logits': 0.5 * nrm(ks[8], (N_HGRN + 1, 2, E), jnp.float32),
        'hg_norm_g': 1.0 + 0.05 * nrm(ks[9], (N_HGRN, HG_HEAD_DIM), jnp.float32),
        'hg_w_out': nrm(ks[10], (N_HGRN, E, D), jnp.float32) * E ** -0.5,
        'ft_w_in': nrm(ks[11], (N_FOURIER, D, 2 * E), jnp.float32) * D ** -0.5,
        'ft_w_out': nrm(ks[12], (N_FOURIER, E, D), jnp.float32) * E ** -0.5,
        'final_g': 1.0 + 0.05 * nrm(ks[13], (D,), jnp.float32),
    }


def reference(x, c, ctx, c_ctx, ada_w, ada_b, norm_g, hg_w_in, hg_lb_logits, hg_norm_g,
              hg_w_out, ft_w_in, ft_w_out, final_g):
    x_lat, x_ctx = x, ctx
    for i in range(DEPTH):
        ctx_out = i < DEPTH - 1
        j = i // N_MIXERS
        sh_l, sc_l, gt_l = adaln(c, ada_w[i], ada_b[i])
        h_lat = rms_norm(x_lat, norm_g[i]) * (1.0 + sc_l[:, None]) + sh_l[:, None]
        if i % N_MIXERS == 0:
            sh_c, sc_c, gt_c = adaln(c_ctx, ada_w[i], ada_b[i])
            h_ctx = rms_norm(x_ctx, norm_g[i]) * (1.0 + sc_c) + sh_c
            lb = hgrn_lower_bound(hg_lb_logits, j)
            y_lat, y_ctx = hgrn_mixer(h_ctx, h_lat, hg_w_in[j], lb, hg_norm_g[j], hg_w_out[j], ctx_out)
        else:
            y_lat = fourier_mixer(h_lat, ft_w_in[j], ft_w_out[j])
            if ctx_out:
                sh_c, sc_c, gt_c = adaln(c_ctx, ada_w[i], ada_b[i])
                h_ctx = rms_norm(x_ctx, norm_g[i]) * (1.0 + sc_c) + sh_c
                y_ctx = fourier_mixer(h_ctx, ft_w_in[j], ft_w_out[j])
        x_lat = x_lat + gt_l[:, None] * y_lat
        if ctx_out:
            x_ctx = x_ctx + gt_c * y_ctx
    return rms_norm(x_lat, final_g)
```

```cpp
#include <hip/hip_runtime.h>
#include <cstdio>
#include <cstdint>

#ifndef SIMPLE_FFTA
#define SIMPLE_FFTA 0
#endif
#ifndef SIMPLE_FFTBC
#define SIMPLE_FFTBC 0
#endif
#ifndef PROBE_MASK
#define PROBE_MASK 0
#endif
#ifndef SIMPLE_SCAN
#define SIMPLE_SCAN 0
#endif
#ifndef MK_N_LAUNCHES
#define MK_N_LAUNCHES 1
#endif

namespace pg8 {
#define PG8_LAS __attribute__((address_space(3)))
typedef unsigned short h16_t;
typedef short bf16x8 __attribute__((ext_vector_type(8)));
typedef _Float16 f16x8 __attribute__((ext_vector_type(8)));
typedef float f32x4 __attribute__((ext_vector_type(4)));
typedef unsigned u32x4 __attribute__((ext_vector_type(4)));
constexpr int BM = 256, BK = 64, HALF = 128, HTB = HALF * BK * 2, STAGE_BYTES = 8 * HTB, NXCD = 8, WGM = 8;

__host__ __device__ __forceinline__ int lds_byte(int r, int c) { const int st = (r >> 4) * 2 + (c >> 5), rr = r & 15, cc = c & 31, ob = rr * 64 + cc * 2; return st * 1024 + (ob ^ (((ob >> 9) & 1) << 5)); }
__host__ __device__ __forceinline__ void stage_rc(int b, int& R, int& C) { const int st = b / 1024, sb = b % 1024, swz = sb ^ (((sb >> 9) & 1) << 5); R = (st >> 1) * 16 + swz / 64; C = (st & 1) * 32 + (swz % 64) / 2; }
__host__ __device__ __forceinline__ int perm32(int rho) { const int n = rho >> 4, i = rho & 15; return 8 * (i >> 2) + 4 * n + (i & 3); }

struct Unit { int pm, pn; };
struct Gemm {
    const char* A; const char* Bt; int M, N, K;
    int a_rs;
    int a_k1;
    long a_k2;
    int a_tdiv; long a_thi, a_tlo;
};
__host__ __device__ __forceinline__ Gemm make_gemm(const void* A, const void* Bt, int M, int N, int K) {
    Gemm g; g.A = (const char*)A; g.Bt = (const char*)Bt; g.M = M; g.N = N; g.K = K; g.a_rs = K * 2; g.a_k1 = BK * 2; g.a_k2 = BK * 4; g.a_tdiv = 1 << 30; g.a_thi = 0; g.a_tlo = (long)BM * K * 2; return g;
}

struct StaticOrder {
    int nM, nN, nwg, G, c;
    __host__ __device__ void init(int M, int N, int G_, int c_) { nM = M / BM; nN = N / BM; nwg = nM * nN; G = G_; c = c_; }
    __host__ __device__ bool next(int i, Unit& u) const {
        const long L = (long)i * G + c; if (L >= nwg) return false;
        int wgid = (int)L; { const int q = nwg / NXCD, r = nwg % NXCD, xcd = wgid % NXCD, off = wgid / NXCD; wgid = (xcd < r ? xcd * (q + 1) : r * (q + 1) + (xcd - r) * q) + off; }
        const int nig = WGM * nN, gid = wgid / nig, fm = gid * WGM, gsz = (nM - fm) < WGM ? (nM - fm) : WGM;
        u.pm = fm + ((wgid % nig) % gsz); u.pn = (wgid % nig) / gsz; return true;
    }
    __device__ __forceinline__ void a_ready(const Unit&) const {}
    __device__ __forceinline__ void done(const Unit&) const {}
};

template <class F> struct EpiElem {
    static constexpr bool PERM = false, AFTER_DRAIN = false;
    F f;
    __device__ __forceinline__ void operator()(const f32x4 (&acc)[2][2][4][2], const Unit& u, int wr, int wc, int fr, int fq) const {
        asm volatile("" : "+v"(fr), "+v"(fq));
#pragma unroll
        for (int ai = 0; ai < 2; ++ai)
#pragma unroll
            for (int m = 0; m < 4; ++m) {
                const int row = u.pm * BM + ai * HALF + wr * 64 + m * 16 + fr;
#pragma unroll
                for (int bj = 0; bj < 2; ++bj)
#pragma unroll
                    for (int n = 0; n < 2; ++n) {
                        const int col = u.pn * BM + bj * HALF + wc * 32 + n * 16 + fq * 4;
                        f(row, col, acc[ai][bj][m][n]);
                    }
            }
    }
};

template <class Epi, class Sched, bool ALIGN_EPI = false, bool SP2 = false>
__device__ __forceinline__ void gemm_phase(PG8_LAS unsigned char* lds, const Gemm g, const Sched& S, const Epi& E, int tid_in) {
    int tid_ = tid_in; asm volatile("" : "+v"(tid_));
    const int tid = tid_, wid = __builtin_amdgcn_readfirstlane(tid >> 6), lane = tid & 63, wr = wid >> 2, wc = wid & 3, fr = lane & 15, fq = lane >> 4;
    const int K = g.K, nt = K / BK;
    unsigned voffA[2], voffB[2];
#pragma unroll
    for (int i = 0; i < 2; ++i) { int R, C; stage_rc(tid * 16 + i * 8192, R, C); const int Rb = Epi::PERM ? ((R & ~31) + perm32(R & 31)) : R;
        voffA[i] = (unsigned)(R * g.a_rs + C * 2); voffB[i] = (unsigned)(Rb * K + C) * 2u; }
    const size_t kstepB = (size_t)(BK * 2);
    const size_t hstepA = (size_t)HALF * g.a_rs, hstepB = (size_t)HALF * K * 2, tstepB = 2 * hstepB;
    const size_t k1A = (size_t)g.a_k1, k2A = (size_t)g.a_k2;
    const unsigned ldsw = (unsigned)wid * 1024u;
    const int aoff = lds_byte(wr * 64 + fr, fq * 8), boff = lds_byte(wc * 32 + fr, fq * 8);
#define PG8_ATOFF(pm) ((size_t)((pm) / g.a_tdiv) * (size_t)g.a_thi + (size_t)((pm) % g.a_tdiv) * (size_t)g.a_tlo)
#define PG8_SA(b, h) (((b) * 2 + (h)) * HTB)
#define PG8_SB(b, h) ((4 + (b) * 2 + (h)) * HTB)
#define PG8_STAGE(bufoff, gbase, voff) do { _Pragma("unroll") for (int _i = 0; _i < 2; ++_i) \
        __builtin_amdgcn_global_load_lds((const unsigned*)((const char*)(gbase) + (voff)[_i]), (PG8_LAS unsigned*)(lds + (bufoff) + ldsw + _i * 8192), 16, 0, 0); } while (0)
#define PG8_LDA(dst, b, h) do { _Pragma("unroll") for (int m = 0; m < 4; ++m) _Pragma("unroll") for (int k = 0; k < 2; ++k) dst[m][k] = *(const PG8_LAS bf16x8*)(lds + PG8_SA(b, h) + aoff + m * 2048 + k * 1024); } while (0)
#define PG8_LDB(dst, b, h) do { _Pragma("unroll") for (int n = 0; n < 2; ++n) _Pragma("unroll") for (int k = 0; k < 2; ++k) dst[n][k] = *(const PG8_LAS bf16x8*)(lds + PG8_SB(b, h) + boff + n * 2048 + k * 1024); } while (0)
#define PG8_MMA(ai, bj, At, Bt) do { __builtin_amdgcn_s_setprio(1); _Pragma("unroll") for (int m = 0; m < 4; ++m) _Pragma("unroll") for (int n = 0; n < 2; ++n) _Pragma("unroll") for (int k = 0; k < 2; ++k) \
        acc[ai][bj][m][n] = __builtin_amdgcn_mfma_f32_16x16x32_f16(__builtin_bit_cast(f16x8, Bt[n][k]), __builtin_bit_cast(f16x8, At[m][k]), acc[ai][bj][m][n], 0, 0, 0); __builtin_amdgcn_s_setprio(0); } while (0)
#define PG8_WAIT_V(n) asm volatile("s_waitcnt vmcnt(" #n ")" ::: "memory")
#define PG8_WAIT_L(n) asm volatile("s_waitcnt lgkmcnt(" #n ")" ::: "memory")
#define PG8_BAR __builtin_amdgcn_s_barrier()
#define PG8_SCHED __builtin_amdgcn_sched_barrier(0)
    Unit cur, nxt; int ui = 0;
    if (!S.next(0, cur)) return;
    f32x4 acc[2][2][4][2];
#pragma unroll
    for (int a = 0; a < 2; ++a)
#pragma unroll
        for (int b = 0; b < 2; ++b)
#pragma unroll
            for (int m = 0; m < 4; ++m)
#pragma unroll
                for (int n = 0; n < 2; ++n) acc[a][b][m][n] = (f32x4){0.f, 0.f, 0.f, 0.f};
    bf16x8 At[4][2], B0[2][2], B1[2][2];
    const char* cA = g.A + PG8_ATOFF(cur.pm); const char* cB = g.Bt + (size_t)cur.pn * tstepB;
    S.a_ready(cur);
    if constexpr (SP2) {
        PG8_STAGE(PG8_SB(0, 0), cB, voffB); PG8_STAGE(PG8_SB(0, 1), cB + hstepB, voffB); PG8_STAGE(PG8_SA(0, 0), cA, voffA); PG8_STAGE(PG8_SA(0, 1), cA + hstepA, voffA);
        if (wr == 1) PG8_BAR;
        PG8_WAIT_V(2); PG8_BAR;
        PG8_STAGE(PG8_SB(1, 0), cB + kstepB, voffB); PG8_STAGE(PG8_SA(1, 0), cA + k1A, voffA); PG8_STAGE(PG8_SB(1, 1), cB + hstepB + kstepB, voffB);
        PG8_WAIT_V(6); PG8_BAR;
    } else {
        PG8_STAGE(PG8_SB(0, 0), cB, voffB); PG8_STAGE(PG8_SA(0, 0), cA, voffA); PG8_STAGE(PG8_SB(0, 1), cB + hstepB, voffB); PG8_STAGE(PG8_SA(0, 1), cA + hstepA, voffA);
        if (wr == 1) PG8_BAR;
        PG8_WAIT_V(4); PG8_BAR;
        PG8_STAGE(PG8_SB(1, 0), cB + kstepB, voffB); PG8_STAGE(PG8_SA(1, 0), cA + k1A, voffA); PG8_STAGE(PG8_SB(1, 1), cB + hstepB + kstepB, voffB);
        PG8_WAIT_V(6); PG8_BAR;
    }
    for (;;) {
        const bool has_next = S.next(ui + 1, nxt);
        const char* nA = has_next ? g.A + PG8_ATOFF(nxt.pm) : cA; const char* nB = has_next ? g.Bt + (size_t)nxt.pn * tstepB : cB;
        for (int t = 0; t < nt; t += 2) {
            const bool last = (t == nt - 2);
            const char* aT = cA + (size_t)(t >> 1) * k2A;
            const char* a1 = aT + k1A;
            const char* a2 = last ? nA : aT + k2A; const char* b2 = last ? nB : cB + (size_t)(t + 2) * kstepB;
            const char* a3 = a2 + k1A; const char* b3 = b2 + kstepB;
            if (last && has_next) S.a_ready(nxt);
            if constexpr (SP2) {
            PG8_LDB(B0, 0, 0); PG8_LDB(B1, 0, 1); PG8_SCHED; PG8_LDA(At, 0, 0); PG8_STAGE(PG8_SA(1, 1), a1 + hstepA, voffA);
            PG8_WAIT_V(8); PG8_WAIT_L(0); PG8_BAR; PG8_MMA(0, 0, At, B0); PG8_MMA(0, 1, At, B1); PG8_BAR; PG8_SCHED;
            PG8_LDA(At, 0, 1); PG8_STAGE(PG8_SB(0, 0), b2, voffB); PG8_STAGE(PG8_SB(0, 1), b2 + hstepB, voffB); PG8_STAGE(PG8_SA(0, 0), a2, voffA);
            PG8_WAIT_V(8); PG8_WAIT_L(0); PG8_BAR; PG8_MMA(1, 0, At, B0); PG8_MMA(1, 1, At, B1); PG8_BAR; PG8_SCHED;
            PG8_LDB(B0, 1, 0); PG8_LDB(B1, 1, 1); PG8_SCHED; PG8_LDA(At, 1, 0); PG8_STAGE(PG8_SA(0, 1), a2 + hstepA, voffA);
            PG8_WAIT_V(8); PG8_WAIT_L(0); PG8_BAR; PG8_MMA(0, 0, At, B0); PG8_MMA(0, 1, At, B1); PG8_BAR; PG8_SCHED;
            PG8_LDA(At, 1, 1); PG8_STAGE(PG8_SB(1, 0), b3, voffB); PG8_STAGE(PG8_SB(1, 1), b3 + hstepB, voffB); PG8_STAGE(PG8_SA(1, 0), a3, voffA);
            PG8_WAIT_V(8); PG8_WAIT_L(0); PG8_BAR; PG8_MMA(1, 0, At, B0); PG8_MMA(1, 1, At, B1); PG8_BAR; PG8_SCHED;
            } else {
            PG8_LDB(B0, 0, 0); PG8_SCHED; PG8_LDA(At, 0, 0); PG8_STAGE(PG8_SA(1, 1), a1 + hstepA, voffA);
            PG8_WAIT_L(8); PG8_BAR; PG8_WAIT_L(0); PG8_MMA(0, 0, At, B0); PG8_BAR; PG8_SCHED;
            PG8_LDB(B1, 0, 1); PG8_STAGE(PG8_SB(0, 0), b2, voffB);
            PG8_BAR; PG8_WAIT_L(0); PG8_MMA(0, 1, At, B1); PG8_BAR;
            PG8_LDA(At, 0, 1); PG8_STAGE(PG8_SA(0, 0), a2, voffA);
            PG8_BAR; PG8_WAIT_L(0); PG8_MMA(1, 0, At, B0); PG8_BAR; PG8_SCHED;
            PG8_STAGE(PG8_SB(0, 1), b2 + hstepB, voffB);
            PG8_WAIT_V(6); PG8_BAR; PG8_MMA(1, 1, At, B1); PG8_BAR;
            PG8_LDB(B0, 1, 0); PG8_SCHED; PG8_LDA(At, 1, 0); PG8_STAGE(PG8_SA(0, 1), a2 + hstepA, voffA);
            PG8_WAIT_L(8); PG8_BAR; PG8_WAIT_L(0); PG8_MMA(0, 0, At, B0); PG8_BAR; PG8_SCHED;
            PG8_LDB(B1, 1, 1); PG8_STAGE(PG8_SB(1, 0), b3, voffB);
            PG8_BAR; PG8_WAIT_L(0); PG8_MMA(0, 1, At, B1); PG8_BAR;
            PG8_LDA(At, 1, 1); PG8_STAGE(PG8_SA(1, 0), a3, voffA);
            PG8_BAR; PG8_WAIT_L(0); PG8_MMA(1, 0, At, B0); PG8_BAR; PG8_SCHED;
            PG8_STAGE(PG8_SB(1, 1), b3 + hstepB, voffB);
            PG8_WAIT_V(6); PG8_BAR; PG8_MMA(1, 1, At, B1); PG8_BAR;
            }
        }
        if constexpr (ALIGN_EPI) { if (wr == 0) PG8_BAR; }
        if constexpr (!Epi::AFTER_DRAIN) { E(acc, cur, wr, wc, fr, fq); S.done(cur); }
        if (!has_next) break;
#pragma unroll
        for (int a = 0; a < 2; ++a)
#pragma unroll
            for (int b = 0; b < 2; ++b)
#pragma unroll
                for (int m = 0; m < 4; ++m)
#pragma unroll
                    for (int n = 0; n < 2; ++n) acc[a][b][m][n] = (f32x4){0.f, 0.f, 0.f, 0.f};
        cur = nxt; cA = nA; cB = nB; ++ui;
        if constexpr (ALIGN_EPI) { if (wr == 1) PG8_BAR; }
    }
    PG8_WAIT_V(0);
    if constexpr (!ALIGN_EPI) { if (wr == 0) PG8_BAR; }
    PG8_BAR;
    if constexpr (Epi::AFTER_DRAIN) { E.fused(acc, cur, wr, wc, fr, fq, lds, wid, lane); S.done(cur); }
#undef PG8_ATOFF
#undef PG8_SA
#undef PG8_SB
#undef PG8_STAGE
#undef PG8_LDA
#undef PG8_LDB
#undef PG8_MMA
#undef PG8_WAIT_V
#undef PG8_WAIT_L
#undef PG8_BAR
#undef PG8_SCHED
}
}

constexpr int NWAVES = 8;
constexpr int BATCH = 2, T = 8192, D = 1024, E = 2048, CTX = 256, NH = 16, HD = 128;
constexpr int M = BATCH * T;
constexpr int MC = BATCH * CTX;
constexpr int HPH = 8;
constexpr int NINH = 5 * HPH * HD;
constexpr float EPS = 1e-6f;
constexpr int N_PHASES = 13;

constexpr size_t MiB = 1u << 20, KiB = 1u << 10;
constexpr size_t WS_CTL = 0, CTL_ZERO_BYTES = 256 * KiB;
constexpr size_t WS_MOD = 256 * KiB;
constexpr size_t WS_LB = 320 * KiB;
constexpr size_t WS_F128 = 384 * KiB;
constexpr size_t WS_G64 = 448 * KiB;
constexpr size_t WS_FCT = 512 * KiB;
constexpr size_t WS_TWC = 768 * KiB, WS_TWS = 800 * KiB;
constexpr size_t WS_DVEC = 1 * MiB;
constexpr size_t WS_XCH = 1536 * KiB;
constexpr size_t WS_FTOUT = 3 * MiB;
constexpr size_t WS_WIN = 7 * MiB;
constexpr size_t WS_WOUT = 27 * MiB;
constexpr size_t WS_H0C = 31 * MiB;
constexpr size_t WS_H0 = 32 * MiB;
constexpr size_t WS_Q = 64 * MiB;
constexpr size_t WS_GF = 128 * MiB, WS_GB = 160 * MiB, WS_V = 192 * MiB, WS_Z = 224 * MiB;
constexpr size_t WS_H1P = 128 * MiB;
constexpr size_t WS_UT = 192 * MiB;
constexpr size_t WS_BP1 = 128 * MiB;
constexpr size_t WS_Y1 = 192 * MiB;
constexpr size_t WS_END = 256 * MiB;
constexpr size_t O_PST = 0;
constexpr size_t O_CTXS = 32 * MiB;
constexpr size_t O_FTIN = 40 * MiB;
constexpr size_t O_SCTX = 48 * MiB;
constexpr size_t O_BP0 = 0;

constexpr int CW_TMO = 0, CW_CODE = 1, CW_BAR = 4096;

constexpr int RING_OFF = 0, RING_BYTES = 131072;
constexpr int LDS_BYTES = 163840;
constexpr int MISC_OFF = LDS_BYTES - 256;
constexpr int STAB_OFF = 135168;

#define GAS __attribute__((address_space(1)))
#define LAS __attribute__((address_space(3)))
typedef unsigned short h16;
typedef unsigned v4u __attribute__((ext_vector_type(4)));
typedef unsigned v2u __attribute__((ext_vector_type(2)));
typedef float f32x4 __attribute__((ext_vector_type(4)));
typedef float f32x2 __attribute__((ext_vector_type(2)));
typedef _Float16 hf2 __attribute__((ext_vector_type(2)));
typedef GAS unsigned gu32;
#define RLX_AGENT __ATOMIC_RELAXED, __HIP_MEMORY_SCOPE_AGENT
#define LDS_WAIT() asm volatile("s_waitcnt lgkmcnt(0)" ::: "memory")
#define VM_WAIT() asm volatile("s_waitcnt vmcnt(0)" ::: "memory")
__device__ __forceinline__ h16 f2h(float f) { _Float16 h = (_Float16)f; return __builtin_bit_cast(h16, h); }
__device__ __forceinline__ float h2f(h16 u) { return (float)__builtin_bit_cast(_Float16, u); }
__device__ __forceinline__ unsigned pk2h(float lo, float hi) { f32x2 v = {lo, hi}; hf2 h = __builtin_convertvector(v, hf2); return __builtin_bit_cast(unsigned, h); }
__device__ __forceinline__ float silu_f(float x) { return x / (1.f + __expf(-x)); }
__device__ __forceinline__ float sigmoid_f(float x) { return 1.f / (1.f + __expf(-x)); }

#define XB_TMO      128
#define XB_XCNT(j)  (256  + 64 * (j))
#define XB_XSUB(j)  (1280 + 64 * (j))
#define XB_XGEN(j)  (2304 + 64 * (j))
#define XB_TOP      3328
#define XB_TOPGEN   3392
#define XCD_BAR_WORDS 3456
#define XB_SPIN_CAP (1u << 18)
__device__ __forceinline__ unsigned xb_ld(unsigned* p)              { return __hip_atomic_load(p, __ATOMIC_RELAXED, __HIP_MEMORY_SCOPE_AGENT); }
__device__ __forceinline__ unsigned xb_add(unsigned* p, unsigned v) { return __hip_atomic_fetch_add(p, v, __ATOMIC_RELAXED, __HIP_MEMORY_SCOPE_AGENT); }
__device__ __forceinline__ unsigned xb_xcc_id() { return (unsigned)__builtin_amdgcn_s_getreg((3 << 11) | 20) & 0xFu; }
#define XB_SPIN(cond, bar) do { unsigned _sp = 0; while (cond) { __builtin_amdgcn_s_sleep(1); \
    if ((++_sp & 255u) == 0u) { if (xb_ld(&(bar)[XB_TMO])) break; if (_sp > XB_SPIN_CAP) { atomicAdd(&(bar)[XB_TMO], 1u); break; } } } } while (0)
struct XcdBarrier { unsigned* bar; unsigned x; volatile LAS unsigned* st; };
__device__ __forceinline__ XcdBarrier xcd_barrier_post(unsigned* bar, volatile LAS unsigned* st) {
    XcdBarrier b; b.bar = bar; b.x = xb_xcc_id(); b.st = st;
    if (threadIdx.x == 0) (void)xb_add(&bar[XB_XCNT(b.x)], 1u);
    return b;
}
__device__ __forceinline__ void xcd_barrier_complete(unsigned* bar, unsigned x, unsigned& nloc, unsigned& nx) {
    const unsigned G = gridDim.x * gridDim.y * gridDim.z;
    unsigned sum, cnt, mine, sp = 0u;
    for (;;) {
        sum = 0u; cnt = 0u; mine = 0u;
#pragma unroll
        for (unsigned j = 0; j < 16; ++j) { const unsigned c = xb_ld(&bar[XB_XCNT(j)]); sum += c; cnt += (c > 0u) ? 1u : 0u; mine = (j == x) ? c : mine; }
        if (sum == G) break;
        __builtin_amdgcn_s_sleep(1);
        if ((++sp & 255u) == 0u) { if (xb_ld(&bar[XB_TMO])) break; if (sp > XB_SPIN_CAP) { atomicAdd(&bar[XB_TMO], 1u); break; } }
    }
    nloc = mine > 0u ? mine : 1u; nx = cnt > 0u ? cnt : 1u;
}
__device__ __forceinline__ void xcd_barrier(const XcdBarrier& b) {
    asm volatile("s_waitcnt vmcnt(0)" ::: "memory");
    __syncthreads();
    if (threadIdx.x == 0) {
        unsigned* bar = b.bar;
        __builtin_amdgcn_s_waitcnt(0);
        unsigned nloc = b.st[0], nx = b.st[1];
        if (nloc == 0u) { xcd_barrier_complete(bar, b.x, nloc, nx); b.st[0] = nloc; b.st[1] = nx; }
        const unsigned old = xb_add(&bar[XB_XSUB(b.x)], 1u);
        const unsigned gen = old / nloc;
        if (old + 1u == (gen + 1u) * nloc) {
            __builtin_amdgcn_fence(__ATOMIC_RELEASE, "agent");
            asm volatile("s_waitcnt vmcnt(0)" ::: "memory");
            const unsigned og = xb_add(&bar[XB_TOP], 1u);
            const unsigned tg = og / nx;
            if (og + 1u == (tg + 1u) * nx) xb_add(&bar[XB_TOPGEN], 1u);
            else XB_SPIN(xb_ld(&bar[XB_TOPGEN]) == tg, bar);
            __builtin_amdgcn_fence(__ATOMIC_ACQUIRE, "agent");
            xb_add(&bar[XB_XGEN(b.x)], 1u);
            asm volatile("s_waitcnt vmcnt(0)" ::: "memory");
        } else {
            XB_SPIN(xb_ld(&bar[XB_XGEN(b.x)]) == gen, bar);
            __builtin_amdgcn_fence(__ATOMIC_ACQUIRE, "agent");
            asm volatile("s_waitcnt vmcnt(0)" ::: "memory");
        }
    }
    __syncthreads();
}

struct Frame {
    LAS unsigned char* lds;
    volatile LAS unsigned* MISC;
    gu32* ctl;
    int tid, lane, wave;
    int vcu, G;
    const float *x, *c, *ctx, *c_ctx, *ada_w, *ada_b, *norm_g, *hg_w_in, *hg_lb, *hg_ng, *hg_w_out, *ft_w_in, *ft_w_out, *final_g;
    unsigned char* ws; unsigned char* o;
};

__device__ __forceinline__ int my_lane() { unsigned z = 0u; asm volatile("" : "+v"(z)); return (int)__builtin_amdgcn_mbcnt_hi(~0u, __builtin_amdgcn_mbcnt_lo(~0u, z)); }
__device__ __forceinline__ float wave_sum(float v) {
#pragma unroll
    for (int o = 1; o < 64; o <<= 1) v += __shfl_xor(v, o);
    return v;
}

__device__ __forceinline__ void p0_transpose_item(const float* W, int K, int N, int k0, int n0, h16* WT, int out_row0, LAS float* scr, int lane) {
#pragma unroll 8
    for (int i = 0; i < 32; ++i) { const int kk = 2 * i + (lane >> 5); scr[kk * 33 + (lane & 31)] = W[(size_t)(k0 + kk) * N + n0 + (lane & 31)]; }
    LDS_WAIT(); asm volatile("" ::: "memory");
    const int c = lane & 7;
#pragma unroll
    for (int j = 0; j < 4; ++j) { const int n = (lane >> 3) + 8 * j; const LAS float* s = scr + (8 * c) * 33 + n;
        v4u o; o.x = pk2h(s[0 * 33], s[1 * 33]); o.y = pk2h(s[2 * 33], s[3 * 33]); o.z = pk2h(s[4 * 33], s[5 * 33]); o.w = pk2h(s[6 * 33], s[7 * 33]);
        *(GAS v4u*)(WT + (size_t)(out_row0 + n) * K + k0 + 8 * c) = o; }
    LDS_WAIT(); asm volatile("" ::: "memory");
}
__device__ __forceinline__ void p0_prologue(Frame& F) {
    {
        LAS float* red = (LAS float*)(F.lds + RING_OFF);
        LAS float* sc = (LAS float*)(F.lds + RING_OFF + 8192);
        bool have = false;
        for (int it = F.vcu; it < 192; it += F.G) {
            if (!have) {
                for (int k = F.tid; k < 3 * D; k += NWAVES * 64) { const int v = k / D, kk = k % D; const float cv = (v == 0) ? F.c[kk] : (v == 1) ? F.c[D + kk] : F.c_ctx[kk]; sc[k] = silu_f(cv); }
                __syncthreads(); have = true;
            }
            const int i = it / 96, n0 = (it % 96) * 32, nl = F.tid & 31, kg = F.tid >> 5;
            const float* W = F.ada_w + (size_t)i * D * 3 * D + n0 + nl;
            float a0 = 0.f, a1 = 0.f, a2 = 0.f;
#pragma unroll 16
            for (int k = kg * 64; k < kg * 64 + 64; ++k) { const float w = W[(size_t)k * (3 * D)]; a0 += sc[k] * w; a1 += sc[D + k] * w; a2 += sc[2 * D + k] * w; }
            red[(kg * 3 + 0) * 32 + nl] = a0; red[(kg * 3 + 1) * 32 + nl] = a1; red[(kg * 3 + 2) * 32 + nl] = a2;
            __syncthreads();
            if (F.tid < 96) { const int v = F.tid >> 5, n = F.tid & 31; float s = 0.f;
#pragma unroll
                for (int q = 0; q < 16; ++q) s += red[(q * 3 + v) * 32 + n];
                s += F.ada_b[i * 3 * D + n0 + n];
                float* mod = (float*)(F.ws + WS_MOD);
                if (i == 0) mod[v * 3 * D + n0 + n] = s; else if (v < 2) mod[(3 + v) * 3 * D + n0 + n] = s; }
            __syncthreads();
        }
        __syncthreads();
    }
    const int gw = F.vcu * NWAVES + F.wave, NGW = F.G * NWAVES;
    const int gt = gw * 64 + F.lane, NGT = NGW * 64;
    {
        float* lbv = (float*)(F.ws + WS_LB);
        for (int i = gt; i < 2 * E; i += NGT) { const float l0 = F.hg_lb[i], l1 = F.hg_lb[2 * E + i]; lbv[i] = 1.f / (1.f + __expf(l1 - l0)); }
        h16* f128 = (h16*)(F.ws + WS_F128);
        for (int i = gt; i < 256 * 128; i += NGT) { const int r = i >> 7, n1 = i & 127, k1 = r & 127; float s, c; sincospif(2.f * (float)((k1 * n1) & 127) / 128.f, &s, &c);
            const float v = (r < 128 ? c : -s) * 0.08838834764831845f; f128[i] = f2h(v); }
        h16* g64 = (h16*)(F.ws + WS_G64);
        for (int i = gt; i < 128 * 128; i += NGT) { const int r = i >> 7, cc = i & 127, k2 = r & 63, n2 = cc & 63; float s, c; sincospif(2.f * (float)((k2 * n2) & 63) / 64.f, &s, &c);
            float v; if (r < 64) v = (cc < 64) ? c : s; else v = (cc < 64) ? -s : c; g64[i] = f2h(v * 0.125f); }
        h16* fct = (h16*)(F.ws + WS_FCT);
        for (int i = gt; i < 256 * 512; i += NGT) { const int m = i >> 9, cc = i & 511, j = cc & 255; float s, c; sincospif(2.f * (float)((j * m) & 255) / 256.f, &s, &c);
            fct[i] = f2h((cc < 256 ? c : s) * 0.0625f); }
        float* twc = (float*)(F.ws + WS_TWC); float* tws = (float*)(F.ws + WS_TWS);
        for (int i = gt; i < 128 * 64; i += NGT) { const int k1 = i >> 6, n2 = i & 63; float s, c; sincospif(2.f * (float)(k1 * n2) / 8192.f, &s, &c); twc[i] = c; tws[i] = s; }
    }
    {
        LAS float* scr = (LAS float*)(F.lds + RING_OFF + F.wave * 16384);
        constexpr int I_IN = (D / 64) * (5 * E / 32), I_OUT = (E / 64) * (D / 32), I_FI = (D / 64) * (2 * E / 32), I_FO = (E / 64) * (D / 32);
        constexpr int NITEMS = I_IN + I_OUT + I_FI + I_FO;
        for (int it = gw; it < NITEMS; it += NGW) {
            int r = it;
            if (r < I_IN) { const int nblk = 5 * E / 32, kb = r / nblk, nb = r % nblk, n0 = nb * 32; const int s = n0 / E, h = (n0 % E) / HD, d0 = n0 % HD;
                const int rho = (h / HPH) * NINH + s * (HPH * HD) + (h % HPH) * HD + d0;
                p0_transpose_item(F.hg_w_in, D, 5 * E, kb * 64, n0, (h16*)(F.ws + WS_WIN), rho, scr, F.lane); continue; } r -= I_IN;
            if (r < I_OUT) { const int nblk = D / 32, kb = r / nblk, nb = r % nblk; p0_transpose_item(F.hg_w_out, E, D, kb * 64, nb * 32, (h16*)(F.ws + WS_WOUT), nb * 32, scr, F.lane); continue; } r -= I_OUT;
            if (r < I_FI) { const int nblk = 2 * E / 32, kb = r / nblk, nb = r % nblk; p0_transpose_item(F.ft_w_in, D, 2 * E, kb * 64, nb * 32, (h16*)(F.o + O_FTIN), nb * 32, scr, F.lane); continue; } r -= I_FI;
            { const int nblk = D / 32, kb = r / nblk, nb = r % nblk; p0_transpose_item(F.ft_w_out, E, D, kb * 64, nb * 32, (h16*)(F.ws + WS_FTOUT), nb * 32, scr, F.lane); }
        }
    }
}

__device__ __forceinline__ void modnorm_row(const f32x4 (&v)[4], const float* g, const float* sh, const float* scl, h16* orow, int lane) {
    float s2 = 0.f;
#pragma unroll
    for (int j = 0; j < 4; ++j) s2 += (v[j].x * v[j].x + v[j].y * v[j].y) + (v[j].z * v[j].z + v[j].w * v[j].w);
    const float rstd = 1.f / sqrtf(wave_sum(s2) * (1.f / D) + EPS);
    GAS v2u* o8 = (GAS v2u*)orow + lane;
#pragma unroll
    for (int j = 0; j < 4; ++j) {
        const f32x4 gg = *((const GAS f32x4*)g + lane + 64 * j), ss = *((const GAS f32x4*)sh + lane + 64 * j), cc = *((const GAS f32x4*)scl + lane + 64 * j);
        const f32x4 h = v[j] * rstd * gg * (cc + 1.f) + ss;
        v2u w; w.x = pk2h(h.x, h.y); w.y = pk2h(h.z, h.w); o8[64 * j] = w;
    }
}
__device__ __forceinline__ void p_norm0(Frame& F) {
    const int gw = F.vcu * NWAVES + F.wave, NGW = F.G * NWAVES;
    const float* mod = (const float*)(F.ws + WS_MOD);
    for (int m = gw; m < M + MC; m += NGW) {
        const float* xrow; h16* orow; int mv;
        if (m < M) { xrow = F.x + (size_t)m * D; orow = (h16*)(F.ws + WS_H0) + (size_t)m * D; mv = m >> 13; }
        else { const int mc = m - M; xrow = F.ctx + (size_t)mc * D; orow = (h16*)(F.ws + WS_H0C) + (size_t)mc * D; mv = 2; }
        f32x4 v[4];
#pragma unroll
        for (int j = 0; j < 4; ++j) v[j] = *((const GAS f32x4*)xrow + F.lane + 64 * j);
        modnorm_row(v, F.norm_g, mod + mv * 3 * D, mod + mv * 3 * D + D, orow, F.lane);
    }
}
__device__ __forceinline__ void p_norm1(Frame& F) {
    const int gw = F.vcu * NWAVES + F.wave, NGW = F.G * NWAVES;
    const float* mod = (const float*)(F.ws + WS_MOD);
    for (int m = gw; m < M; m += NGW) {
        const int b = m >> 13, t = m & (T - 1), rp = (t & 63) * 128 + (t >> 6);
        const float* xrow = F.x + (size_t)m * D; const h16* drow = (const h16*)(F.ws + WS_H0) + (size_t)m * D;
        h16* orow = (h16*)(F.ws + WS_H1P) + (size_t)(b * T + rp) * D;
        f32x4 v[4];
#pragma unroll
        for (int j = 0; j < 4; ++j) { v[j] = *((const GAS f32x4*)xrow + F.lane + 64 * j); const v2u dd = *((const GAS v2u*)drow + F.lane + 64 * j);
            v[j].x += h2f((h16)(dd.x & 0xffff)); v[j].y += h2f((h16)(dd.x >> 16)); v[j].z += h2f((h16)(dd.y & 0xffff)); v[j].w += h2f((h16)(dd.y >> 16)); }
        modnorm_row(v, F.norm_g + D, mod + (3 + b) * 3 * D, mod + (3 + b) * 3 * D + D, orow, F.lane);
    }
}
__device__ __forceinline__ void p_final(Frame& F) {
    const int gw = F.vcu * NWAVES + F.wave, NGW = F.G * NWAVES;
    for (int m = gw; m < M; m += NGW) {
        const float* xrow = F.x + (size_t)m * D; const h16* drow = (const h16*)(F.ws + WS_H0) + (size_t)m * D; float* orow = (float*)F.o + (size_t)m * D;
        f32x4 v[4]; float s2 = 0.f;
#pragma unroll
        for (int j = 0; j < 4; ++j) { v[j] = *((const GAS f32x4*)xrow + F.lane + 64 * j) + *((const GAS f32x4*)orow + F.lane + 64 * j); const v2u dd = *((const GAS v2u*)drow + F.lane + 64 * j);
            v[j].x += h2f((h16)(dd.x & 0xffff)); v[j].y += h2f((h16)(dd.x >> 16)); v[j].z += h2f((h16)(dd.y & 0xffff)); v[j].w += h2f((h16)(dd.y >> 16));
            s2 += (v[j].x * v[j].x + v[j].y * v[j].y) + (v[j].z * v[j].z + v[j].w * v[j].w); }
        const float rstd = 1.f / sqrtf(wave_sum(s2) * (1.f / D) + EPS);
#pragma unroll
        for (int j = 0; j < 4; ++j) { const f32x4 gg = *((const GAS f32x4*)F.final_g + F.lane + 64 * j); *((GAS f32x4*)orow + F.lane + 64 * j) = v[j] * rstd * gg; }
    }
}

struct EpiInProj0 {
    unsigned char* ws; unsigned char* o; const float* lbv; int half;
    __device__ __forceinline__ void operator()(int row, int col, const f32x4& a) const {
        const int s = col >> 10, hl = (col >> 7) & 7, d = col & 127;
        const bool isctx = row < MC;
        int b, t; if (isctx) { b = row >> 8; t = row & 255; } else { const int m = row - MC; b = m >> 13; t = m & (T - 1); }
        float r[4];
        if (s == 0 || s == 4) { if (isctx) return;
#pragma unroll
            for (int j = 0; j < 4; ++j) r[j] = silu_f(a[j]); }
        else if (s == 3) {
#pragma unroll
            for (int j = 0; j < 4; ++j) r[j] = a[j]; }
        else { const float* lb = lbv + (s - 1) * E + (half * HPH + hl) * HD + d;
#pragma unroll
            for (int j = 0; j < 4; ++j) { const float l = lb[j]; const float f = l + (1.f - l) * sigmoid_f(a[j]); r[j] = __logf(f); } }
        v2u w; w.x = pk2h(r[0], r[1]); w.y = pk2h(r[2], r[3]);
        h16* dst;
        if (isctx) dst = (h16*)(o + O_CTXS) + ((size_t)((half * 3 + (s - 1)) * BATCH + b) * HPH + hl) * (CTX * HD) + (size_t)t * HD + d;
        else if (s == 0) dst = (h16*)(ws + WS_Q) + ((size_t)(b * NH + half * HPH + hl) * T + t) * HD + d;
        else { const size_t base = (s == 1) ? WS_GF : (s == 2) ? WS_GB : (s == 3) ? WS_V : WS_Z; dst = (h16*)(ws + base) + ((size_t)(b * HPH + hl) * T + t) * HD + d; }
        *(GAS v2u*)dst = w;
    }
};
struct EpiOut0 {
    unsigned char* ws; const float* mod;
    __device__ __forceinline__ void operator()(int row, int col, const f32x4& a) const {
        const int b = row >> 13; const f32x4 gt = *(const GAS f32x4*)(mod + b * 3 * D + 2 * D + col);
        v2u w; w.x = pk2h(a[0] * gt[0], a[1] * gt[1]); w.y = pk2h(a[2] * gt[2], a[3] * gt[3]);
        *(GAS v2u*)((h16*)(ws + WS_H0) + (size_t)row * D + col) = w;
    }
};
struct EpiU {
    unsigned char* ws;
    __device__ __forceinline__ void operator()(int row, int col, const f32x4& a) const {
        const int b = col >> 13, rp = col & (T - 1);
        v2u w; w.x = pk2h(a[0], a[1]); w.y = pk2h(a[2], a[3]);
        *(GAS v2u*)((h16*)(ws + WS_UT) + ((size_t)(b * E + row) * T + rp)) = w;
    }
};
struct EpiZ {
    unsigned char* ws;
    __device__ __forceinline__ void operator()(int row, int col, const f32x4& a) const {
        const int b = row >> 13, rp = row & (T - 1), t = 64 * (rp & 127) + (rp >> 7);
        v2u w; w.x = pk2h(silu_f(a[0]), silu_f(a[1])); w.y = pk2h(silu_f(a[2]), silu_f(a[3]));
        *(GAS v2u*)((h16*)(ws + WS_Q) + ((size_t)(b * T + t) * E + col)) = w;
    }
};
struct EpiOut1 {
    unsigned char* o; const float* mod;
    __device__ __forceinline__ void operator()(int row, int col, const f32x4& a) const {
        const int b = row >> 13; const f32x4 gt = *(const GAS f32x4*)(mod + (3 + b) * 3 * D + 2 * D + col);
        *(GAS f32x4*)((float*)o + (size_t)row * D + col) = a * gt;
    }
};

__device__ __forceinline__ void p_scan_simple(Frame& F, int half) {
    LAS float* qs = (LAS float*)(F.lds + RING_OFF);
    LAS float* fs = qs + 1024; LAS float* ks = fs + 1024; LAS float* vs = ks + 1024;
    LAS float* op = vs + 1024;
    LAS float* red = op + 4096;
    const int dv = F.tid & 127, cq = F.tid >> 7;
    for (int it = F.vcu; it < BATCH * HPH; it += F.G) {
        const int b = it / HPH, hl = it % HPH, h = half * HPH + hl;
        h16* qb = (h16*)(F.ws + WS_Q) + (size_t)(b * NH + h) * T * HD;
        h16* vb = (h16*)(F.ws + WS_V) + (size_t)(b * HPH + hl) * T * HD;
        h16* zb = (h16*)(F.ws + WS_Z) + (size_t)(b * HPH + hl) * T * HD;
        h16* gbb = (h16*)(F.ws + WS_GB) + (size_t)(b * HPH + hl) * T * HD;
        const float ng = F.hg_ng[dv];
        for (int dir = 1; dir >= 0; --dir) {
            h16* gl = (h16*)(F.ws + (dir ? WS_GB : WS_GF)) + (size_t)(b * HPH + hl) * T * HD;
            const h16* gc = (const h16*)(F.o + O_CTXS) + ((size_t)((half * 3 + dir) * BATCH + b) * HPH + hl) * (CTX * HD);
            const h16* vc = (const h16*)(F.o + O_CTXS) + ((size_t)((half * 3 + 2) * BATCH + b) * HPH + hl) * (CTX * HD);
            float S[32];
#pragma unroll
            for (int i = 0; i < 32; ++i) S[i] = 0.f;
            const int nblk = (CTX + T) / 8;
            for (int bi = 0; bi < nblk; ++bi) {
                const bool isctx = bi < CTX / 8;
                const int bl = isctx ? bi : bi - CTX / 8, nb = isctx ? CTX / 8 : T / 8;
                const int t0 = (dir ? (nb - 1 - bl) : bl) * 8;
#pragma unroll
                for (int e = 0; e < 2; ++e) { const int idx = F.tid + e * 512, off = t0 * HD + idx;
                    const float g = h2f(isctx ? gc[off] : gl[off]); const float f = __expf(g);
                    fs[idx] = f; ks[idx] = 1.f - f; vs[idx] = h2f(isctx ? vc[off] : vb[off]); qs[idx] = isctx ? 0.f : h2f(qb[off]); }
                __syncthreads();
#pragma unroll 1
                for (int j = 0; j < 8; ++j) { const int jj = dir ? 7 - j : j; const float vv = vs[jj * 128 + dv]; float po = 0.f;
#pragma unroll
                    for (int i = 0; i < 32; ++i) { const int c = cq * 32 + i; S[i] = fs[jj * 128 + c] * S[i] + ks[jj * 128 + c] * vv; po += S[i] * qs[jj * 128 + c]; }
                    op[(jj * 4 + cq) * 128 + dv] = po; }
                __syncthreads();
                if (!isctx) {
                    float ov[2];
#pragma unroll
                    for (int e = 0; e < 2; ++e) { const int jj = (F.tid >> 7) + 4 * e; ov[e] = (op[(jj * 4 + 0) * 128 + dv] + op[(jj * 4 + 1) * 128 + dv]) + (op[(jj * 4 + 2) * 128 + dv] + op[(jj * 4 + 3) * 128 + dv]); }
                    if (dir == 1) {
#pragma unroll
                        for (int e = 0; e < 2; ++e) { const int jj = (F.tid >> 7) + 4 * e; gbb[(size_t)(t0 + jj) * HD + dv] = f2h(ov[e]); }
                    } else {
#pragma unroll
                        for (int e = 0; e < 2; ++e) { const int jj = (F.tid >> 7) + 4 * e; ov[e] += h2f(gbb[(size_t)(t0 + jj) * HD + dv]);
                            const float ss = wave_sum(ov[e] * ov[e]); if (F.lane == 0) red[jj * 2 + (F.wave & 1)] = ss; }
                        __syncthreads();
#pragma unroll
                        for (int e = 0; e < 2; ++e) { const int jj = (F.tid >> 7) + 4 * e; const float rstd = 1.f / sqrtf((red[jj * 2] + red[jj * 2 + 1]) * (1.f / HD) + EPS);
                            const float y = ov[e] * rstd * ng * h2f(zb[(size_t)(t0 + jj) * HD + dv]); qb[(size_t)(t0 + jj) * HD + dv] = f2h(y); }
                    }
                }
                __syncthreads();
            }
        }
    }
}

typedef short v4s __attribute__((ext_vector_type(4)));
typedef __bf16 bf2_t __attribute__((ext_vector_type(2)));
using pg8::bf16x8; using pg8::f16x8;
constexpr int NSEG = 16, SEGC = 8, CH = 64;
__device__ __forceinline__ unsigned pk2bf(float lo, float hi) { f32x2 v = {lo, hi}; bf2_t b = __builtin_convertvector(v, bf2_t); return __builtin_bit_cast(unsigned, b); }
__device__ __forceinline__ int img_off(int row, int ch) { return 256 * row + 16 * (ch ^ (((row & 3) << 2) | ((row >> 2) & 3))); }
__device__ __forceinline__ bf16x8 row_frag(const LAS unsigned char* img, int rb, int s, int lane) {
    return *(const LAS bf16x8*)(img + img_off((lane & 15) + 16 * rb, 4 * s + (lane >> 4)));
}
__device__ __forceinline__ bf16x8 tr_frag(const LAS unsigned char* img, int c, int ks, int lane) {
    const int g = lane >> 4, q = (lane & 15) >> 2, p = lane & 3;
    const int a0 = img_off(32 * ks + 8 * g + q, 2 * c + (p >> 1)) + 8 * (p & 1);
    const int a1 = img_off(32 * ks + 8 * g + 4 + q, 2 * c + (p >> 1)) + 8 * (p & 1);
    const v4s lo = __builtin_bit_cast(v4s, __builtin_amdgcn_ds_read_tr16_b64_v4i16((LAS v4s*)(img + a0)));
    const v4s hi = __builtin_bit_cast(v4s, __builtin_amdgcn_ds_read_tr16_b64_v4i16((LAS v4s*)(img + a1)));
    return (bf16x8){lo[0], lo[1], lo[2], lo[3], hi[0], hi[1], hi[2], hi[3]};
}
__device__ __forceinline__ float h_lo(unsigned u) { return h2f((h16)(u & 0xffff)); }
__device__ __forceinline__ float h_hi(unsigned u) { return h2f((h16)(u >> 16)); }
__device__ __forceinline__ float* pst_ptr(Frame& F, int dir, int b, int hl, int seg) { return (float*)(F.o + O_PST) + ((size_t)(((dir * BATCH + b) * HPH + hl) * NSEG + seg) << 14); }
__device__ __forceinline__ float* sctx_ptr(Frame& F, int dir, int b, int hl) { return (float*)(F.o + O_SCTX) + ((size_t)((dir * BATCH + b) * HPH + hl) << 14); }
__device__ __forceinline__ float* dvec_ptr(Frame& F, int dir, int b, int hl, int seg) { return (float*)(F.ws + WS_DVEC) + (size_t)((((dir * BATCH + b) * HPH + hl) * NSEG + seg) << 7); }
__device__ __forceinline__ void st_store(float* P, const f32x4 (&St)[8], int w, int fr, int fq) {
#pragma unroll
    for (int ct = 0; ct < 8; ++ct)
#pragma unroll
        for (int r = 0; r < 4; ++r) P[(16 * w + 4 * fq + r) * 128 + 16 * ct + fr] = St[ct][r];
}
__device__ __forceinline__ void st_load(const float* P, f32x4 (&St)[8], int w, int fr, int fq) {
#pragma unroll
    for (int ct = 0; ct < 8; ++ct)
#pragma unroll
        for (int r = 0; r < 4; ++r) St[ct][r] = P[(16 * w + 4 * fq + r) * 128 + 16 * ct + fr];
}

__device__ __forceinline__ void p1_run(Frame& F, const unsigned char* base, unsigned gf, unsigned gb, unsigned vv, int nch, f32x4 (&Pf)[8], f32x4 (&Pb)[8], float (&totf)[2], float (&rhead)[2]) {
    LAS unsigned char* lds = F.lds;
    constexpr int KF = 0, KB = 16384, VI = 32768, TOTF = 49152, TOTB = 53248, DCH = 57344;
    const int tid = F.tid, w = F.wave, cp = tid & 63, tg = tid >> 6;
    LAS float* totF = (LAS float*)(lds + TOTF); LAS float* totB = (LAS float*)(lds + TOTB); LAS float* dch = (LAS float*)(lds + DCH);
    unsigned ugf[8], ugb[8], uv[8];
#define P1_LD(off) (*(const GAS unsigned*)(base + (size_t)(unsigned)(off)))
    { const unsigned tb = (unsigned)((tg * 8) * HD + 2 * cp) * 2u;
#pragma unroll
      for (int i = 0; i < 8; ++i) { ugf[i] = P1_LD(gf + tb + i * HD * 2); ugb[i] = P1_LD(gb + tb + i * HD * 2); uv[i] = P1_LD(vv + tb + i * HD * 2); } }
#pragma unroll 1
    for (int ci = 0; ci < nch; ++ci) {
        int lane = F.lane; asm volatile("" : "+v"(lane));
        const int fr = lane & 15;
        float gf0[8], gf1[8], gb0[8], gb1[8]; float sf0 = 0.f, sf1 = 0.f, sb0 = 0.f, sb1 = 0.f;
#pragma unroll
        for (int i = 0; i < 8; ++i) { gf0[i] = h_lo(ugf[i]); gf1[i] = h_hi(ugf[i]); gb0[i] = h_lo(ugb[i]); gb1[i] = h_hi(ugb[i]); sf0 += gf0[i]; sf1 += gf1[i]; sb0 += gb0[i]; sb1 += gb1[i]; }
        *(LAS f32x2*)(totF + tg * 128 + 2 * cp) = (f32x2){sf0, sf1}; *(LAS f32x2*)(totB + tg * 128 + 2 * cp) = (f32x2){sb0, sb1};
        __syncthreads();
        float suf0 = 0.f, suf1 = 0.f, pre0 = rhead[0], pre1 = rhead[1], all_f0 = 0.f, all_f1 = 0.f, all_b0 = 0.f, all_b1 = 0.f;
#pragma unroll
        for (int g2 = 0; g2 < 8; ++g2) { const f32x2 tf = *(const LAS f32x2*)(totF + g2 * 128 + 2 * cp), tbv = *(const LAS f32x2*)(totB + g2 * 128 + 2 * cp);
            all_f0 += tf.x; all_f1 += tf.y; all_b0 += tbv.x; all_b1 += tbv.y;
            if (g2 > tg) { suf0 += tf.x; suf1 += tf.y; } if (g2 < tg) { pre0 += tbv.x; pre1 += tbv.y; } }
        float rs0 = suf0, rs1 = suf1;
        unsigned kfw[8], kbw[8];
#pragma unroll
        for (int i = 7; i >= 0; --i) { const float k0 = (1.f - __expf(gf0[i])) * __expf(rs0), k1 = (1.f - __expf(gf1[i])) * __expf(rs1); kfw[i] = pk2h(k0, k1); rs0 += gf0[i]; rs1 += gf1[i]; }
#pragma unroll
        for (int i = 0; i < 8; ++i) { const float k0 = (1.f - __expf(gb0[i])) * __expf(pre0), k1 = (1.f - __expf(gb1[i])) * __expf(pre1); kbw[i] = pk2h(k0, k1); pre0 += gb0[i]; pre1 += gb1[i]; }
#pragma unroll
        for (int i = 0; i < 8; ++i) { const int o = img_off(tg * 8 + i, cp >> 2) + (cp & 3) * 4;
            *(LAS unsigned*)(lds + KF + o) = kfw[i]; *(LAS unsigned*)(lds + KB + o) = kbw[i]; *(LAS unsigned*)(lds + VI + o) = uv[i]; }
        if (tg == 0) *(LAS f32x2*)(dch + 2 * cp) = (f32x2){__expf(all_f0), __expf(all_f1)};
        totf[0] += all_f0; totf[1] += all_f1; rhead[0] += all_b0; rhead[1] += all_b1;
        if (ci + 1 < nch) { const unsigned tb = (unsigned)(((ci + 1) * CH + tg * 8) * HD + 2 * cp) * 2u;
#pragma unroll
            for (int i = 0; i < 8; ++i) { ugf[i] = P1_LD(gf + tb + i * HD * 2); ugb[i] = P1_LD(gb + tb + i * HD * 2); uv[i] = P1_LD(vv + tb + i * HD * 2); } }
        __syncthreads();
        bf16x8 va[2];
#pragma unroll
        for (int ks = 0; ks < 2; ++ks) va[ks] = tr_frag(lds + VI, w, ks, lane);
#pragma unroll
        for (int ct = 0; ct < 8; ++ct) { const float d = dch[16 * ct + fr]; Pf[ct] = Pf[ct] * d;
#pragma unroll
            for (int ks = 0; ks < 2; ++ks) {
                const bf16x8 kf_ = tr_frag(lds + KF, ct, ks, lane), kb_ = tr_frag(lds + KB, ct, ks, lane);
                Pf[ct] = __builtin_amdgcn_mfma_f32_16x16x32_f16(__builtin_bit_cast(f16x8, va[ks]), __builtin_bit_cast(f16x8, kf_), Pf[ct], 0, 0, 0);
                Pb[ct] = __builtin_amdgcn_mfma_f32_16x16x32_f16(__builtin_bit_cast(f16x8, va[ks]), __builtin_bit_cast(f16x8, kb_), Pb[ct], 0, 0, 0); } }
    }
    __syncthreads();
#undef P1_LD
}
__device__ __forceinline__ void p_scan1(Frame& F, int half) {
    const int w = F.wave, fr = F.lane & 15, fq = F.lane >> 4, cp = F.tid & 63, tg = F.tid >> 6;
    for (int it = F.vcu; it < BATCH * HPH * NSEG; it += F.G) {
        const int b = it / (HPH * NSEG), hl = (it / NSEG) % HPH, seg = it % NSEG;
        f32x4 Pf[8], Pb[8]; float totf[2], rhead[2];
        if (seg == 0) {
#pragma unroll
            for (int ct = 0; ct < 8; ++ct) { Pf[ct] = (f32x4){0.f, 0.f, 0.f, 0.f}; Pb[ct] = (f32x4){0.f, 0.f, 0.f, 0.f}; }
            totf[0] = totf[1] = rhead[0] = rhead[1] = 0.f;
            const unsigned cs = (unsigned)(CTX * HD * 2), o0 = (unsigned)O_CTXS + (unsigned)(((half * 3 + 0) * BATCH + b) * HPH + hl) * cs, o1 = (unsigned)O_CTXS + (unsigned)(((half * 3 + 1) * BATCH + b) * HPH + hl) * cs, o2 = (unsigned)O_CTXS + (unsigned)(((half * 3 + 2) * BATCH + b) * HPH + hl) * cs;
            p1_run(F, F.o, o0, o1, o2, CTX / CH, Pf, Pb, totf, rhead);
            st_store(sctx_ptr(F, 0, b, hl), Pf, w, fr, fq); st_store(sctx_ptr(F, 1, b, hl), Pb, w, fr, fq);
        }
#pragma unroll
        for (int ct = 0; ct < 8; ++ct) { Pf[ct] = (f32x4){0.f, 0.f, 0.f, 0.f}; Pb[ct] = (f32x4){0.f, 0.f, 0.f, 0.f}; }
        totf[0] = totf[1] = rhead[0] = rhead[1] = 0.f;
        const unsigned so = (unsigned)(((b * HPH + hl) * T + seg * SEGC * CH) * HD) * 2u;
        p1_run(F, F.ws, (unsigned)WS_GF + so, (unsigned)WS_GB + so, (unsigned)WS_V + so, SEGC, Pf, Pb, totf, rhead);
        st_store(pst_ptr(F, 0, b, hl, seg), Pf, w, fr, fq); st_store(pst_ptr(F, 1, b, hl, seg), Pb, w, fr, fq);
        if (tg == 0) { *(GAS f32x2*)(dvec_ptr(F, 0, b, hl, seg) + 2 * cp) = (f32x2){__expf(totf[0]), __expf(totf[1])}; *(GAS f32x2*)(dvec_ptr(F, 1, b, hl, seg) + 2 * cp) = (f32x2){__expf(rhead[0]), __expf(rhead[1])}; }
    }
}
__device__ __forceinline__ void p_scan_combine(Frame& F) {
    for (int it = F.vcu; it < 2 * BATCH * HPH * 8; it += F.G) {
        const int sl = it & 7, hl = (it >> 3) % HPH, b = (it >> 3) / HPH % BATCH, dir = (it >> 3) / (HPH * BATCH);
        const int e = sl * 2048 + F.tid * 4, c = e & 127;
        f32x4 tmp[NSEG];
        float* const p0 = pst_ptr(F, dir, b, hl, 0) + e; const float* const d0 = dvec_ptr(F, dir, b, hl, 0) + c;
#pragma unroll
        for (int j = 0; j < NSEG; ++j) tmp[j] = *(const GAS f32x4*)(p0 + ((size_t)j << 14));
        f32x4 Tt = *(const GAS f32x4*)(sctx_ptr(F, dir, b, hl) + e);
#pragma unroll 1
        for (int jj = 0; jj < NSEG; ++jj) { const int j = dir ? NSEG - 1 - jj : jj; const f32x4 dd = *(const GAS f32x4*)(d0 + (j << 7));
            f32x4 tj = tmp[0];
#pragma unroll
            for (int q = 1; q < NSEG; ++q) tj = (q == j) ? tmp[q] : tj;
            *(GAS f32x4*)(p0 + ((size_t)j << 14)) = Tt; Tt = Tt * dd + tj; }
    }
}
template <int DIR> __device__ __forceinline__ void p2_sweep(Frame& F, unsigned qb, unsigned gb_, unsigned vb, unsigned zb, unsigned pb, f32x4 (&St)[8], bool dummy = false) {
    unsigned char* const wsb = F.ws;
#define P2_U32(off) (*(const GAS unsigned*)(wsb + (size_t)(unsigned)(off)))
#define P2_V4(off) (*(GAS v4u*)(wsb + (size_t)(unsigned)(off)))
    LAS unsigned char* lds = F.lds;
    constexpr int QI = 0, KI = 16384, VI = 32768, AI = 49152, SI = 65536, OB = 98304, TOT = 132096, EB = 136192, E2 = 136704;
    const int tid = F.tid, w = F.wave, cp = tid & 63, tg = tid >> 6;
    LAS float* tot = (LAS float*)(lds + TOT); LAS float* eb = (LAS float*)(lds + EB); LAS float* e2 = (LAS float*)(lds + E2); LAS float* ob = (LAS float*)(lds + OB);
    const int ft = tid >> 3, fj = tid & 7;
    unsigned uq[8], ug[8], uv[8];
    { const unsigned tb = (unsigned)(((DIR ? SEGC - 1 : 0) * CH + tg * 8) * HD + 2 * cp) * 2u;
#pragma unroll
      for (int i = 0; i < 8; ++i) { uq[i] = P2_U32(qb + tb + i * HD * 2); ug[i] = P2_U32(gb_ + tb + i * HD * 2); uv[i] = P2_U32(vb + tb + i * HD * 2); } }
#pragma unroll 1
    for (int step = 0; step < SEGC; ++step) {
        int lane = F.lane; asm volatile("" : "+v"(lane));
        const int fr = lane & 15, fq = lane >> 4;
        const int ci = DIR ? SEGC - 1 - step : step;
        const unsigned co = (unsigned)(ci * CH * HD) * 2u;
        float g0[8], g1[8]; float s0 = 0.f, s1 = 0.f;
#pragma unroll
        for (int i = 0; i < 8; ++i) { g0[i] = h_lo(ug[i]); g1[i] = h_hi(ug[i]); s0 += g0[i]; s1 += g1[i]; }
        *(LAS f32x2*)(tot + tg * 128 + 2 * cp) = (f32x2){s0, s1};
        v4u p0, p1, z0, z1;
        if (DIR == 1) { const unsigned fo = co + (unsigned)(ft * HD + 16 * fj) * 2u;
            p0 = P2_V4(pb + fo); p1 = P2_V4(pb + fo + 16); z0 = P2_V4(zb + fo); z1 = P2_V4(zb + fo + 16); }
        __syncthreads();
        float pre0 = 0.f, pre1 = 0.f, be0 = 0.f, be1 = 0.f, al0 = 0.f, al1 = 0.f;
#pragma unroll
        for (int g2 = 0; g2 < 8; ++g2) { const f32x2 tv = *(const LAS f32x2*)(tot + g2 * 128 + 2 * cp); al0 += tv.x; al1 += tv.y;
            if (DIR == 0) { if (g2 < tg) { pre0 += tv.x; pre1 += tv.y; } if (g2 < 4) { be0 += tv.x; be1 += tv.y; } }
            else { if (g2 > tg) { pre0 += tv.x; pre1 += tv.y; } if (g2 >= 4) { be0 += tv.x; be1 += tv.y; } } }
        {
            float r0 = pre0, r1 = pre1;
#pragma unroll
            for (int ii = 0; ii < 8; ++ii) { const int i = DIR ? 7 - ii : ii;
                r0 += g0[i]; r1 += g1[i];
                const float e0 = __expf(r0 - be0), e1 = __expf(r1 - be1), i0 = __expf(be0 - r0), i1 = __expf(be1 - r1);
                const float k0 = 1.f - __expf(g0[i]), k1 = 1.f - __expf(g1[i]);
                const int o = img_off(tg * 8 + i, cp >> 2) + (cp & 3) * 4;
                *(LAS unsigned*)(lds + QI + o) = pk2bf(h_lo(uq[i]) * e0, h_hi(uq[i]) * e1);
                *(LAS unsigned*)(lds + KI + o) = pk2bf(k0 * i0, k1 * i1);
                *(LAS unsigned*)(lds + VI + o) = pk2bf(h_lo(uv[i]), h_hi(uv[i])); }
        }
        if (tg == 0) { *(LAS f32x2*)(eb + 2 * cp) = (f32x2){__expf(be0), __expf(be1)}; *(LAS f32x2*)(e2 + 2 * cp) = (f32x2){__expf(al0 - be0), __expf(al1 - be1)}; }
        if (step + 1 < SEGC) { const unsigned tb = (unsigned)(((DIR ? ci - 1 : ci + 1) * CH + tg * 8) * HD + 2 * cp) * 2u;
#pragma unroll
            for (int i = 0; i < 8; ++i) { uq[i] = P2_U32(qb + tb + i * HD * 2); ug[i] = P2_U32(gb_ + tb + i * HD * 2); uv[i] = P2_U32(vb + tb + i * HD * 2); } }
        __syncthreads();
#pragma unroll
        for (int ct = 0; ct < 8; ++ct) { St[ct] = St[ct] * eb[16 * ct + fr];
            v2u wv; wv.x = pk2bf(St[ct][0], St[ct][1]); wv.y = pk2bf(St[ct][2], St[ct][3]);
            *(LAS v2u*)(lds + SI + img_off(16 * ct + fr, 2 * w + (fq >> 1)) + (fq & 1) * 8) = wv; }
        {
            const int ti = w >> 1;
            f32x4 sc[2] = {(f32x4){0.f, 0.f, 0.f, 0.f}, (f32x4){0.f, 0.f, 0.f, 0.f}};
#pragma unroll
            for (int ks = 0; ks < 4; ++ks) { const bf16x8 qf = row_frag(lds + QI, ti, ks, lane);
#pragma unroll
                for (int u = 0; u < 2; ++u) { const bf16x8 kf = row_frag(lds + KI, 2 * (w & 1) + u, ks, lane); sc[u] = __builtin_amdgcn_mfma_f32_16x16x32_bf16(kf, qf, sc[u], 0, 0, 0); } }
#pragma unroll
            for (int u = 0; u < 2; ++u) { const int sj = 2 * (w & 1) + u, t = 16 * ti + fr; float m[4];
#pragma unroll
                for (int r = 0; r < 4; ++r) { const int sidx = 16 * sj + 4 * fq + r; const bool keep = DIR ? (sidx >= t) : (sidx <= t); m[r] = keep ? sc[u][r] : 0.f; }
                v2u wv; wv.x = pk2bf(m[0], m[1]); wv.y = pk2bf(m[2], m[3]);
                *(LAS v2u*)(lds + AI + img_off(t, 2 * sj + (fq >> 1)) + (fq & 1) * 8) = wv; }
        }
        __syncthreads();
        f32x4 oacc[4];
#pragma unroll
        for (int ti = 0; ti < 4; ++ti) oacc[ti] = (f32x4){0.f, 0.f, 0.f, 0.f};
        bf16x8 va[2];
#pragma unroll
        for (int ks = 0; ks < 2; ++ks) { va[ks] = tr_frag(lds + VI, w, ks, lane);
#pragma unroll
            for (int ti = 0; ti < 4; ++ti) { const bf16x8 af = row_frag(lds + AI, ti, ks, lane); oacc[ti] = __builtin_amdgcn_mfma_f32_16x16x32_bf16(va[ks], af, oacc[ti], 0, 0, 0); } }
#pragma unroll
        for (int ks = 0; ks < 4; ++ks) { const bf16x8 sf = tr_frag(lds + SI, w, ks, lane);
#pragma unroll
            for (int ti = 0; ti < 4; ++ti) { const bf16x8 qf = row_frag(lds + QI, ti, ks, lane); oacc[ti] = __builtin_amdgcn_mfma_f32_16x16x32_bf16(sf, qf, oacc[ti], 0, 0, 0); } }
#pragma unroll
        for (int ct = 0; ct < 8; ++ct) {
#pragma unroll
            for (int ks = 0; ks < 2; ++ks) { const bf16x8 kf = tr_frag(lds + KI, ct, ks, lane); St[ct] = __builtin_amdgcn_mfma_f32_16x16x32_bf16(va[ks], kf, St[ct], 0, 0, 0); }
            St[ct] = St[ct] * e2[16 * ct + fr]; }
#pragma unroll
        for (int ti = 0; ti < 4; ++ti) *(LAS f32x4*)(ob + (16 * ti + fr) * 132 + 16 * w + 4 * fq) = oacc[ti];
        __syncthreads();
        {
            f32x4 ov[4];
#pragma unroll
            for (int i = 0; i < 4; ++i) ov[i] = *(const LAS f32x4*)(ob + ft * 132 + 16 * fj + 4 * i);
            const unsigned fo = co + (unsigned)(ft * HD + 16 * fj) * 2u;
            const unsigned dmy = (unsigned)(WS_H0) + (unsigned)(blockIdx.x & 31) * (unsigned)(SEGC * CH * HD * 2);
            if (DIR == 0) {
                v4u w0, w1; w0.x = pk2h(ov[0][0], ov[0][1]); w0.y = pk2h(ov[0][2], ov[0][3]); w0.z = pk2h(ov[1][0], ov[1][1]); w0.w = pk2h(ov[1][2], ov[1][3]);
                w1.x = pk2h(ov[2][0], ov[2][1]); w1.y = pk2h(ov[2][2], ov[2][3]); w1.z = pk2h(ov[3][0], ov[3][1]); w1.w = pk2h(ov[3][2], ov[3][3]);
                const unsigned dst = (dummy ? dmy : pb) + fo; P2_V4(dst) = w0; P2_V4(dst + 16) = w1;
            } else {
                const unsigned pu[8] = {p0.x, p0.y, p0.z, p0.w, p1.x, p1.y, p1.z, p1.w}, zu[8] = {z0.x, z0.y, z0.z, z0.w, z1.x, z1.y, z1.z, z1.w};
                float o16[16]; float ss = 0.f;
#pragma unroll
                for (int i = 0; i < 8; ++i) { o16[2 * i] = ov[i >> 1][(2 * i) & 3] + h_lo(pu[i]); o16[2 * i + 1] = ov[i >> 1][(2 * i + 1) & 3] + h_hi(pu[i]); ss += o16[2 * i] * o16[2 * i] + o16[2 * i + 1] * o16[2 * i + 1]; }
                ss += __shfl_xor(ss, 1); ss += __shfl_xor(ss, 2); ss += __shfl_xor(ss, 4);
                const float rstd = 1.f / sqrtf(ss * (1.f / HD) + EPS);
                unsigned yo[8];
#pragma unroll
                for (int i = 0; i < 8; ++i) { const f32x2 ng = *(const GAS f32x2*)(F.hg_ng + 16 * fj + 2 * i);
                    yo[i] = pk2h(o16[2 * i] * rstd * ng.x * h_lo(zu[i]), o16[2 * i + 1] * rstd * ng.y * h_hi(zu[i])); }
                const unsigned dst = (dummy ? dmy : qb) + fo; P2_V4(dst) = (v4u){yo[0], yo[1], yo[2], yo[3]}; P2_V4(dst + 16) = (v4u){yo[4], yo[5], yo[6], yo[7]};
            }
        }
    }
    __syncthreads();
#undef P2_U32
#undef P2_V4
}
__device__ __forceinline__ void p_scan2(Frame& F, int half, bool dummy = false) {
    const int w = F.wave, fr = F.lane & 15, fq = F.lane >> 4;
    for (int it = F.vcu; it < BATCH * HPH * NSEG; it += F.G) {
        const int b = it / (HPH * NSEG), hl = (it / NSEG) % HPH, seg = it % NSEG, h = half * HPH + hl;
        const unsigned qb = (unsigned)WS_Q + (unsigned)(((b * NH + h) * T + seg * SEGC * CH) * HD) * 2u;
        const unsigned so = (unsigned)(((b * HPH + hl) * T + seg * SEGC * CH) * HD) * 2u;
        const unsigned gfb = (unsigned)WS_GF + so, gbb = (unsigned)WS_GB + so, vb = (unsigned)WS_V + so, zb = (unsigned)WS_Z + so;
        f32x4 St[8];
        st_load(pst_ptr(F, 0, b, hl, seg), St, w, fr, fq);
        p2_sweep<0>(F, qb, gfb, vb, zb, gfb, St, dummy);
        st_load(pst_ptr(F, 1, b, hl, seg), St, w, fr, fq);
        p2_sweep<1>(F, qb, gbb, vb, zb, gfb, St, dummy);
    }
}

__device__ __forceinline__ h16* bp_ptr(Frame& F, int b) { return (h16*)(b == 0 ? F.o + O_BP0 : F.ws + WS_BP1); }
__device__ __forceinline__ void p_fftA_simple(Frame& F) {
    LAS float* us = (LAS float*)(F.lds + RING_OFF);
    LAS float* tc = us + 8192; LAS float* ts = tc + 128;
    if (F.tid < 128) { float s, c; sincospif(2.f * (float)F.tid / 128.f, &s, &c); tc[F.tid] = c; ts[F.tid] = s; }
    const float* twc = (const float*)(F.ws + WS_TWC); const float* tws = (const float*)(F.ws + WS_TWS);
    for (int it = F.vcu; it < BATCH * E; it += F.G) {
        const int b = it / E, ch = it % E;
        const h16* u = (const h16*)(F.ws + WS_UT) + (size_t)(b * E + ch) * T;
        __syncthreads();
        for (int i = F.tid; i < T; i += NWAVES * 64) us[i] = h2f(u[i]);
        __syncthreads();
        const int k1 = F.tid & 127, ng = F.tid >> 7;
        h16* bp = bp_ptr(F, b) + ((size_t)k1 * E + ch) * 128;
        for (int q = 0; q < 16; ++q) { const int n2 = ng * 16 + q; float ar = 0.f, ai = 0.f;
            for (int n1 = 0; n1 < 128; ++n1) { const float uv = us[n2 * 128 + n1]; const int ix = (n1 * k1) & 127; ar += uv * tc[ix]; ai -= uv * ts[ix]; }
            ar *= 0.08838834764831845f; ai *= 0.08838834764831845f;
            const float c = twc[k1 * 64 + n2], s = tws[k1 * 64 + n2];
            bp[n2] = f2h(ar * c + ai * s); bp[64 + n2] = f2h(ai * c - ar * s); }
    }
}
__device__ __forceinline__ void p_fftBC_simple(Frame& F) {
    LAS h16* bt = (LAS h16*)(F.lds + RING_OFF);
    LAS h16* vt = (LAS h16*)(F.lds + RING_OFF + 65536);
    LAS float* t64 = (LAS float*)(F.lds + STAB_OFF);
    LAS float* t256 = t64 + 128;
    if (F.tid < 64) { float s, c; sincospif(2.f * (float)F.tid / 64.f, &s, &c); t64[F.tid] = c; t64[64 + F.tid] = s; }
    if (F.tid < 256) { float s, c; sincospif(2.f * (float)F.tid / 256.f, &s, &c); t256[F.tid] = c; t256[256 + F.tid] = s; }
    for (int it = F.vcu; it < BATCH * 128 * 8; it += F.G) {
        const int b = it / 1024, k1 = (it % 1024) / 8, g = it % 8;
        const h16* bp = bp_ptr(F, b) + ((size_t)k1 * E + g * 256) * 128;
        __syncthreads();
        for (int i = F.tid; i < 256 * 128; i += NWAVES * 64) { const int cch = i >> 7, n = i & 127; bt[cch * 128 + ((n + 2 * cch) & 127)] = bp[i]; }
        __syncthreads();
        const int ch = F.tid & 255, kh = F.tid >> 8;
        for (int q = 0; q < 32; ++q) { const int k2 = kh * 32 + q; float ar = 0.f, ai = 0.f;
            for (int n2 = 0; n2 < 64; ++n2) { const float br = h2f(bt[ch * 128 + ((n2 + 2 * ch) & 127)]), bi = h2f(bt[ch * 128 + ((64 + n2 + 2 * ch) & 127)]); const int ix = (n2 * k2) & 63; const float c = t64[ix], s = t64[64 + ix];
                ar += br * c + bi * s; ai += bi * c - br * s; }
            vt[(k2 * 256 + ch) * 2] = f2h(ar * 0.125f); vt[(k2 * 256 + ch) * 2 + 1] = f2h(ai * 0.125f); }
        __syncthreads();
        const int m = ch;
        for (int q = 0; q < 32; ++q) { const int k2 = kh * 32 + q; float a = 0.f;
            for (int j = 0; j < 256; ++j) { const int ix = (j * m) & 255; a += h2f(vt[(k2 * 256 + j) * 2]) * t256[ix] + h2f(vt[(k2 * 256 + j) * 2 + 1]) * t256[256 + ix]; }
            const size_t idx = (size_t)(b * T + k1 + 128 * k2) * E + g * 256 + m;
            const float zz = h2f(((const h16*)(F.ws + WS_Q))[idx]);
            ((h16*)(F.ws + WS_Y1))[idx] = f2h(a * 0.0625f * zz); }
    }
}

struct EpiFftA {
    static constexpr bool PERM = false, AFTER_DRAIN = false;
    unsigned char* ws; unsigned char* o;
    __device__ __forceinline__ void operator()(const pg8::f32x4 (&acc)[2][2][4][2], const pg8::Unit& u, int wr, int wc, int fr, int fq) const {
        asm volatile("" : "+v"(fr), "+v"(fq));
        const unsigned char* twc = ws + WS_TWC; const unsigned char* tws = ws + WS_TWS;
        const int b = u.pn >> 9, ch0 = (u.pn & 511) * 4;
        unsigned char* bp = (b == 0 ? o + O_BP0 : ws + WS_BP1);
#pragma unroll
        for (int m = 0; m < 4; ++m) {
            const unsigned k1 = (unsigned)(wr * 64 + m * 16 + fr);
#pragma unroll
            for (int bj = 0; bj < 2; ++bj)
#pragma unroll
                for (int n = 0; n < 2; ++n) {
                    const unsigned cl = (unsigned)(bj * 128 + wc * 32 + n * 16 + fq * 4), ch = (unsigned)ch0 + (cl >> 6), n2 = cl & 63u;
                    const unsigned toff = (k1 * 64u + n2) * 4u;
                    const f32x4 c4 = *(const GAS f32x4*)(twc + (size_t)toff), s4 = *(const GAS f32x4*)(tws + (size_t)toff);
                    const f32x4 re = acc[0][bj][m][n], im = acc[1][bj][m][n];
                    const f32x4 orr = re * c4 + im * s4, oi = im * c4 - re * s4;
                    const unsigned doff = ((k1 * (unsigned)E + ch) * 128u + n2) * 2u;
                    v2u w0; w0.x = pk2h(orr[0], orr[1]); w0.y = pk2h(orr[2], orr[3]);
                    v2u w1; w1.x = pk2h(oi[0], oi[1]); w1.y = pk2h(oi[2], oi[3]);
                    *(GAS v2u*)(bp + (size_t)doff) = w0; *(GAS v2u*)(bp + (size_t)doff + 128) = w1;
                    asm volatile("" ::: "memory"); __builtin_amdgcn_sched_barrier(0);
                }
        }
    }
};

__device__ __forceinline__ void bc_stage_half(LAS unsigned char* lds, int ldsoff, const char* gbase, int rs, int tid, int wid) {
#pragma unroll
    for (int i = 0; i < 2; ++i) { int R, C; pg8::stage_rc(tid * 16 + i * 8192, R, C);
        __builtin_amdgcn_global_load_lds((const unsigned*)(gbase + (size_t)R * rs + C * 2), (LAS unsigned*)(lds + ldsoff + wid * 1024 + i * 8192), 16, 0, 0); }
}
__device__ __forceinline__ void p_fftBC(Frame& F) {
    using pg8::f16x8; using pg8::bf16x8;
    LAS unsigned char* lds = F.lds + RING_OFF;
    const int tid = F.tid, wid = F.wave;
    const int rh = wid >> 2, rb = (wid * 32) & 127;
    const char* G = (const char*)(F.ws + WS_G64); const char* FCT = (const char*)(F.ws + WS_FCT);
    constexpr int XO = 0, YO = 65536;
    for (int it = F.vcu; it < BATCH * 128 * 8; it += F.G) {
        const int b = it >> 10, k1 = (it >> 3) & 127, g = it & 7;
        const char* bp = (const char*)(bp_ptr(F, b) + ((size_t)k1 * E + g * 256) * 128);
        int lane = F.lane; asm volatile("" : "+v"(lane));
        const int fr = lane & 15, fq = lane >> 4;
        __syncthreads();
#pragma unroll
        for (int r2 = 0; r2 < 2; ++r2)
#pragma unroll
            for (int kh = 0; kh < 2; ++kh) bc_stage_half(lds, XO + (r2 * 2 + kh) * 16384, bp + (size_t)r2 * 128 * 256 + kh * 128, 256, tid, wid);
#pragma unroll
        for (int kh = 0; kh < 2; ++kh) bc_stage_half(lds, YO + kh * 16384, G + kh * 128, 256, tid, wid);
        VM_WAIT(); __syncthreads();
        f32x4 accB[2][8];
#pragma unroll
        for (int mt = 0; mt < 2; ++mt)
#pragma unroll
            for (int nt = 0; nt < 8; ++nt) accB[mt][nt] = (f32x4){0.f, 0.f, 0.f, 0.f};
#pragma unroll
        for (int kh = 0; kh < 2; ++kh)
#pragma unroll
            for (int kk = 0; kk < 2; ++kk) {
                bf16x8 a[2];
#pragma unroll
                for (int mt = 0; mt < 2; ++mt) a[mt] = *(const LAS bf16x8*)(lds + XO + (rh * 2 + kh) * 16384 + pg8::lds_byte(rb + 16 * mt + fr, kk * 32 + fq * 8));
#pragma unroll
                for (int nt = 0; nt < 8; ++nt) { const bf16x8 bb = *(const LAS bf16x8*)(lds + YO + kh * 16384 + pg8::lds_byte(16 * nt + fr, kk * 32 + fq * 8));
#pragma unroll
                    for (int mt = 0; mt < 2; ++mt) accB[mt][nt] = __builtin_amdgcn_mfma_f32_16x16x32_f16(__builtin_bit_cast(f16x8, a[mt]), __builtin_bit_cast(f16x8, bb), accB[mt][nt], 0, 0, 0); }
            }
        __syncthreads();
#pragma unroll
        for (int mt = 0; mt < 2; ++mt)
#pragma unroll
            for (int nt = 0; nt < 8; ++nt) { const int ch = wid * 32 + 16 * mt + 4 * fq, ri = nt >> 2, k2 = (16 * nt + fr) & 63, kb = ri * 4 + (ch >> 6);
                v2u w; w.x = pk2h(accB[mt][nt][0], accB[mt][nt][1]); w.y = pk2h(accB[mt][nt][2], accB[mt][nt][3]);
                *(LAS v2u*)(lds + YO + kb * 8192 + pg8::lds_byte(k2, ch & 63)) = w; }
#pragma unroll
        for (int d = 0; d < 2; ++d)
#pragma unroll
            for (int r2 = 0; r2 < 2; ++r2) bc_stage_half(lds, XO + d * 32768 + r2 * 16384, FCT + (size_t)r2 * 128 * 1024 + d * 128, 1024, tid, wid);
        f32x4 accC[2][4];
#pragma unroll
        for (int mt = 0; mt < 2; ++mt)
#pragma unroll
            for (int nt = 0; nt < 4; ++nt) accC[mt][nt] = (f32x4){0.f, 0.f, 0.f, 0.f};
#pragma unroll 1
        for (int kt = 0; kt < 8; ++kt) {
            VM_WAIT(); LDS_WAIT(); __syncthreads();
            const int d = kt & 1;
#pragma unroll
            for (int kk = 0; kk < 2; ++kk) {
                bf16x8 a[2];
#pragma unroll
                for (int mt = 0; mt < 2; ++mt) a[mt] = *(const LAS bf16x8*)(lds + XO + d * 32768 + rh * 16384 + pg8::lds_byte(rb + 16 * mt + fr, kk * 32 + fq * 8));
#pragma unroll
                for (int nt = 0; nt < 4; ++nt) { const bf16x8 bb = *(const LAS bf16x8*)(lds + YO + kt * 8192 + pg8::lds_byte(16 * nt + fr, kk * 32 + fq * 8));
#pragma unroll
                    for (int mt = 0; mt < 2; ++mt) accC[mt][nt] = __builtin_amdgcn_mfma_f32_16x16x32_f16(__builtin_bit_cast(f16x8, a[mt]), __builtin_bit_cast(f16x8, bb), accC[mt][nt], 0, 0, 0); }
            }
            if (kt + 2 < 8) { __syncthreads();
#pragma unroll
                for (int r2 = 0; r2 < 2; ++r2) bc_stage_half(lds, XO + d * 32768 + r2 * 16384, FCT + (size_t)r2 * 128 * 1024 + (kt + 2) * 128, 1024, tid, wid); }
        }
#pragma unroll
        for (int mt = 0; mt < 2; ++mt)
#pragma unroll
            for (int nt = 0; nt < 4; ++nt) { const int m = wid * 32 + 16 * mt + 4 * fq, k2 = 16 * nt + fr;
                const size_t idx = (size_t)(b * T + k1 + 128 * k2) * E + g * 256 + m;
                const v2u zz = *(const GAS v2u*)((const h16*)(F.ws + WS_Q) + idx);
                v2u w; w.x = pk2h(accC[mt][nt][0] * h2f((h16)(zz.x & 0xffff)), accC[mt][nt][1] * h2f((h16)(zz.x >> 16)));
                w.y = pk2h(accC[mt][nt][2] * h2f((h16)(zz.y & 0xffff)), accC[mt][nt][3] * h2f((h16)(zz.y >> 16)));
                *(GAS v2u*)((h16*)(F.ws + WS_Y1) + idx) = w; }
    }
}

struct Args { const float* in[14]; float* out; unsigned char* ws; int ph_lo, ph_hi, li, pad; };
__global__ void __launch_bounds__(NWAVES * 64, 2) skel_fwd(Args args) {
    extern __shared__ __attribute__((aligned(16))) unsigned char lds[];
    Frame F;
    F.lds = (LAS unsigned char*)lds;
    F.MISC = (volatile LAS unsigned*)(F.lds + MISC_OFF);
    const int wave_s = __builtin_amdgcn_readfirstlane((int)threadIdx.x >> 6);
    F.tid = threadIdx.x; F.lane = F.tid & 63; F.wave = wave_s;
    F.G = gridDim.x; { const int bx = blockIdx.x; F.vcu = (F.G % 8 == 0) ? (bx % 8) * (F.G / 8) + bx / 8 : bx; }
    F.ws = args.ws; F.o = (unsigned char*)args.out;
    F.ctl = (gu32*)(F.ws + WS_CTL);
    F.x = args.in[0]; F.c = args.in[1]; F.ctx = args.in[2]; F.c_ctx = args.in[3]; F.ada_w = args.in[4]; F.ada_b = args.in[5]; F.norm_g = args.in[6];
    F.hg_w_in = args.in[7]; F.hg_lb = args.in[8]; F.hg_ng = args.in[9]; F.hg_w_out = args.in[10]; F.ft_w_in = args.in[11]; F.ft_w_out = args.in[12]; F.final_g = args.in[13];
    if (F.tid < 32) ((LAS unsigned*)(F.lds + MISC_OFF))[F.tid] = 0u;
    __syncthreads();
    XcdBarrier bar; bar.bar = (unsigned*)(F.ctl + CW_BAR); bar.x = 0; bar.st = nullptr;
    if (MK_N_LAUNCHES == 1) bar = xcd_barrier_post((unsigned*)(F.ctl + CW_BAR), F.MISC + 8);
#define GRID_BAR() do { if (MK_N_LAUNCHES == 1) { xcd_barrier(bar); if ((PROBE_MASK >> 14) & 1) xcd_barrier(bar); } } while (0)
    const int lo = args.ph_lo, hi = args.ph_hi;
#define IN(k) (lo <= (k) && (k) < hi)
#define MYTID() (wave_s * 64 + my_lane())
#define REFRESH() do { int t_ = MYTID(); asm volatile("" : "+v"(t_)); F.tid = t_; F.lane = t_ & 63; F.wave = wave_s; } while (0)
#define BOTH(k) (IN(k) && IN((k) + 1))
    const float* mod = (const float*)(F.ws + WS_MOD);

    if (IN(0)) { for (int rep = 0; rep < 1 + ((PROBE_MASK >> 0) & 1); ++rep) { REFRESH(); p0_prologue(F); } if (BOTH(0)) GRID_BAR(); }
    if (IN(1)) { for (int rep = 0; rep < 1 + ((PROBE_MASK >> 1) & 1); ++rep) { REFRESH(); p_norm0(F); } if (BOTH(1)) GRID_BAR(); }
#pragma unroll 1
    for (int half = 0; half < 2; ++half) {
        if (IN(2 + 2 * half)) for (int rep = 0; rep < 1 + ((PROBE_MASK >> 2) & 1); ++rep) {
            pg8::Gemm g = pg8::make_gemm(F.ws + WS_H0C, F.ws + WS_WIN + (size_t)half * NINH * D * 2, M + MC, NINH, D);
            pg8::StaticOrder S; S.init(M + MC, NINH, F.G, (int)blockIdx.x);
            pg8::EpiElem<EpiInProj0> Ep{EpiInProj0{F.ws, F.o, (const float*)(F.ws + WS_LB), half}};
            pg8::gemm_phase<pg8::EpiElem<EpiInProj0>, pg8::StaticOrder, true, true>(F.lds + RING_OFF, g, S, Ep, MYTID());
            if (rep == ((PROBE_MASK >> 2) & 1) && BOTH(2 + 2 * half)) GRID_BAR();
        }
        if (IN(3 + 2 * half)) {
            REFRESH();
#if SIMPLE_SCAN
            p_scan_simple(F, half);
#else
            for (int rep = 0; rep < 1 + ((PROBE_MASK >> 13) & 1); ++rep) { REFRESH(); p_scan1(F, half); } GRID_BAR(); REFRESH(); p_scan_combine(F); GRID_BAR(); if ((PROBE_MASK >> 15) & 1) { REFRESH(); p_scan2(F, half, true); } REFRESH(); p_scan2(F, half);
#endif
            if (BOTH(3 + 2 * half)) GRID_BAR();
        }
    }
    if (IN(6)) for (int rep = 0; rep < 1 + ((PROBE_MASK >> 6) & 1); ++rep) {
        pg8::Gemm g = pg8::make_gemm(F.ws + WS_Q, F.ws + WS_WOUT, M, D, E);
        g.a_rs = HD * 2; g.a_k1 = 128; g.a_k2 = (long)T * HD * 2; g.a_tdiv = T / 256; g.a_thi = (long)NH * T * HD * 2; g.a_tlo = 256L * HD * 2;
        pg8::StaticOrder S; S.init(M, D, F.G, (int)blockIdx.x);
        pg8::EpiElem<EpiOut0> Ep{EpiOut0{F.ws, mod}};
        pg8::gemm_phase<pg8::EpiElem<EpiOut0>, pg8::StaticOrder, true, true>(F.lds + RING_OFF, g, S, Ep, MYTID());
        if (rep == ((PROBE_MASK >> 6) & 1) && BOTH(6)) GRID_BAR();
    }
    if (IN(7)) { for (int rep = 0; rep < 1 + ((PROBE_MASK >> 7) & 1); ++rep) { REFRESH(); p_norm1(F); } if (BOTH(7)) GRID_BAR(); }
    if (IN(8)) for (int rep = 0; rep < 1 + ((PROBE_MASK >> 8) & 1); ++rep) {
        { pg8::Gemm g = pg8::make_gemm(F.o + O_FTIN, F.ws + WS_H1P, E, M, D);
          pg8::StaticOrder S; S.init(E, M, F.G, (int)blockIdx.x);
          pg8::EpiElem<EpiU> Ep{EpiU{F.ws}};
          pg8::gemm_phase<pg8::EpiElem<EpiU>, pg8::StaticOrder, true, true>(F.lds + RING_OFF, g, S, Ep, MYTID()); }
        __syncthreads();
        { pg8::Gemm g = pg8::make_gemm(F.ws + WS_H1P, F.o + O_FTIN + (size_t)E * D * 2, M, E, D);
          pg8::StaticOrder S; S.init(M, E, F.G, (int)blockIdx.x);
          pg8::EpiElem<EpiZ> Ep{EpiZ{F.ws}};
          pg8::gemm_phase<pg8::EpiElem<EpiZ>, pg8::StaticOrder, true, true>(F.lds + RING_OFF, g, S, Ep, MYTID()); }
        if (rep == ((PROBE_MASK >> 8) & 1) && BOTH(8)) GRID_BAR();
    }
    if (IN(9)) for (int rep = 0; rep < 1 + ((PROBE_MASK >> 9) & 1); ++rep) {
#if SIMPLE_FFTA
        REFRESH(); p_fftA_simple(F);
#else
        int kfa = 128; asm volatile("" : "+s"(kfa));
        pg8::Gemm g = pg8::make_gemm(F.ws + WS_F128, F.ws + WS_UT, 256, BATCH * E * 64, kfa);
        pg8::StaticOrder S; S.init(256, BATCH * E * 64, F.G, (int)blockIdx.x);
        EpiFftA Ep{F.ws, F.o};
        pg8::gemm_phase<EpiFftA, pg8::StaticOrder, true, true>(F.lds + RING_OFF, g, S, Ep, MYTID());
#endif
        if (rep == ((PROBE_MASK >> 9) & 1) && BOTH(9)) GRID_BAR();
    }
    if (IN(10)) for (int rep = 0; rep < 1 + ((PROBE_MASK >> 10) & 1); ++rep) {
        REFRESH();
#if SIMPLE_FFTBC
        p_fftBC_simple(F);
#else
        p_fftBC(F);
#endif
        if (rep == ((PROBE_MASK >> 10) & 1) && BOTH(10)) GRID_BAR();
    }
    if (IN(11)) for (int rep = 0; rep < 1 + ((PROBE_MASK >> 11) & 1); ++rep) {
        pg8::Gemm g = pg8::make_gemm(F.ws + WS_Y1, F.ws + WS_FTOUT, M, D, E);
        pg8::StaticOrder S; S.init(M, D, F.G, (int)blockIdx.x);
        pg8::EpiElem<EpiOut1> Ep{EpiOut1{F.o, mod}};
        pg8::gemm_phase<pg8::EpiElem<EpiOut1>, pg8::StaticOrder, true, true>(F.lds + RING_OFF, g, S, Ep, MYTID());
        if (rep == ((PROBE_MASK >> 11) & 1) && BOTH(11)) GRID_BAR();
    }
    if (IN(12)) { REFRESH(); p_final(F); }
#undef IN
#undef BOTH
}

extern "C" void kernel_launch(void* const* d_in, const int* in_sizes, int n_in, void* d_out, int out_size, void* d_ws, size_t ws_size, hipStream_t stream) {
    static int grid = 0;
    if (grid == 0) {
        if (n_in != 14 || in_sizes[0] != M * D || out_size != M * D || ws_size < WS_END) { fprintf(stderr, "kernel_launch: unexpected shapes (n_in %d, ws %zu)\n", n_in, ws_size); grid = -1; return; }
        int dev = 0, cus = 0, per_cu = 0;
        if (hipGetDevice(&dev) != hipSuccess || hipDeviceGetAttribute(&cus, hipDeviceAttributeMultiprocessorCount, dev) != hipSuccess) { grid = -1; return; }
        if (hipFuncSetAttribute((const void*)skel_fwd, hipFuncAttributeMaxDynamicSharedMemorySize, LDS_BYTES) != hipSuccess) { fprintf(stderr, "kernel_launch: hipFuncSetAttribute failed\n"); grid = -1; return; }
        if (hipOccupancyMaxActiveBlocksPerMultiprocessor(&per_cu, (const void*)skel_fwd, NWAVES * 64, LDS_BYTES) != hipSuccess || per_cu < 1) { fprintf(stderr, "kernel_launch: occupancy query says %d\n", per_cu); per_cu = 1; }
        (void)hipGetLastError();
        grid = cus;
    }
    if (grid < 0) return;
    (void)hipMemsetAsync((char*)d_ws + WS_CTL, 0, CTL_ZERO_BYTES, stream);
    Args a{};
    for (int i = 0; i < 14; ++i) a.in[i] = (const float*)d_in[i];
    a.out = (float*)d_out; a.ws = (unsigned char*)d_ws;
    if (MK_N_LAUNCHES == 1) { a.ph_lo = 0; a.ph_hi = N_PHASES; a.li = 0; hipLaunchKernelGGL(skel_fwd, dim3(grid), dim3(NWAVES * 64), LDS_BYTES, stream, a); }
    else for (int li = 0; li < N_PHASES; ++li) { a.ph_lo = li; a.ph_hi = li + 1; a.li = li; hipLaunchKernelGGL(skel_fwd, dim3(grid), dim3(NWAVES * 64), LDS_BYTES, stream, a); }
}
```

```cpp
#include <hip/hip_runtime.h>
#include <cstdio>
#include <cstdint>

#ifndef SIMPLE_FFTA
#define SIMPLE_FFTA 0
#endif
#ifndef SIMPLE_FFTBC
#define SIMPLE_FFTBC 0
#endif
#ifndef PROBE_MASK
#define PROBE_MASK 0
#endif
#ifndef SIMPLE_SCAN
#define SIMPLE_SCAN 0
#endif
#ifndef MK_N_LAUNCHES
#define MK_N_LAUNCHES 1
#endif

namespace pg8 {
#define PG8_LAS __attribute__((address_space(3)))
typedef unsigned short h16_t;
typedef short bf16x8 __attribute__((ext_vector_type(8)));
typedef _Float16 f16x8 __attribute__((ext_vector_type(8)));
typedef float f32x4 __attribute__((ext_vector_type(4)));
typedef unsigned u32x4 __attribute__((ext_vector_type(4)));
constexpr int BM = 256, BK = 64, HALF = 128, HTB = HALF * BK * 2, STAGE_BYTES = 8 * HTB, NXCD = 8, WGM = 8;

__host__ __device__ __forceinline__ int lds_byte(int r, int c) { const int st = (r >> 4) * 2 + (c >> 5), rr = r & 15, cc = c & 31, ob = rr * 64 + cc * 2; return st * 1024 + (ob ^ (((ob >> 9) & 1) << 5)); }
__host__ __device__ __forceinline__ void stage_rc(int b, int& R, int& C) { const int st = b / 1024, sb = b % 1024, swz = sb ^ (((sb >> 9) & 1) << 5); R = (st >> 1) * 16 + swz / 64; C = (st & 1) * 32 + (swz % 64) / 2; }
__host__ __device__ __forceinline__ int perm32(int rho) { const int n = rho >> 4, i = rho & 15; return 8 * (i >> 2) + 4 * n + (i & 3); }

struct Unit { int pm, pn; };
struct Gemm {
    const char* A; const char* Bt; int M, N, K;
    int a_rs;
    int a_k1;
    long a_k2;
    int a_tdiv; long a_thi, a_tlo;
};
__host__ __device__ __forceinline__ Gemm make_gemm(const void* A, const void* Bt, int M, int N, int K) {
    Gemm g; g.A = (const char*)A; g.Bt = (const char*)Bt; g.M = M; g.N = N; g.K = K; g.a_rs = K * 2; g.a_k1 = BK * 2; g.a_k2 = BK * 4; g.a_tdiv = 1 << 30; g.a_thi = 0; g.a_tlo = (long)BM * K * 2; return g;
}

struct StaticOrder {
    int nM, nN, nwg, G, c;
    __host__ __device__ void init(int M, int N, int G_, int c_) { nM = M / BM; nN = N / BM; nwg = nM * nN; G = G_; c = c_; }
    __host__ __device__ bool next(int i, Unit& u) const {
        const long L = (long)i * G + c; if (L >= nwg) return false;
        int wgid = (int)L; { const int q = nwg / NXCD, r = nwg % NXCD, xcd = wgid % NXCD, off = wgid / NXCD; wgid = (xcd < r ? xcd * (q + 1) : r * (q + 1) + (xcd - r) * q) + off; }
        const int nig = WGM * nN, gid = wgid / nig, fm = gid * WGM, gsz = (nM - fm) < WGM ? (nM - fm) : WGM;
        u.pm = fm + ((wgid % nig) % gsz); u.pn = (wgid % nig) / gsz; return true;
    }
    __device__ __forceinline__ void a_ready(const Unit&) const {}
    __device__ __forceinline__ void done(const Unit&) const {}
};

template <class F> struct EpiElem {
    static constexpr bool PERM = false, AFTER_DRAIN = false;
    F f;
    __device__ __forceinline__ void operator()(const f32x4 (&acc)[2][2][4][2], const Unit& u, int wr, int wc, int fr, int fq) const {
        asm volatile("" : "+v"(fr), "+v"(fq));
#pragma unroll
        for (int ai = 0; ai < 2; ++ai)
#pragma unroll
            for (int m = 0; m < 4; ++m) {
                const int row = u.pm * BM + ai * HALF + wr * 64 + m * 16 + fr;
#pragma unroll
                for (int bj = 0; bj < 2; ++bj)
#pragma unroll
                    for (int n = 0; n < 2; ++n) {
                        const int col = u.pn * BM + bj * HALF + wc * 32 + n * 16 + fq * 4;
                        f(row, col, acc[ai][bj][m][n]);
                    }
            }
    }
};

template <class Epi, class Sched, bool ALIGN_EPI = false, bool SP2 = false>
__device__ __forceinline__ void gemm_phase(PG8_LAS unsigned char* lds, const Gemm g, const Sched& S, const Epi& E, int tid_in) {
    int tid_ = tid_in; asm volatile("" : "+v"(tid_));
    const int tid = tid_, wid = __builtin_amdgcn_readfirstlane(tid >> 6), lane = tid & 63, wr = wid >> 2, wc = wid & 3, fr = lane & 15, fq = lane >> 4;
    const int K = g.K, nt = K / BK;
    unsigned voffA[2], voffB[2];
#pragma unroll
    for (int i = 0; i < 2; ++i) { int R, C; stage_rc(tid * 16 + i * 8192, R, C); const int Rb = Epi::PERM ? ((R & ~31) + perm32(R & 31)) : R;
        voffA[i] = (unsigned)(R * g.a_rs + C * 2); voffB[i] = (unsigned)(Rb * K + C) * 2u; }
    const size_t kstepB = (size_t)(BK * 2);
    const size_t hstepA = (size_t)HALF * g.a_rs, hstepB = (size_t)HALF * K * 2, tstepB = 2 * hstepB;
    const size_t k1A = (size_t)g.a_k1, k2A = (size_t)g.a_k2;
    const unsigned ldsw = (unsigned)wid * 1024u;
    const int aoff = lds_byte(wr * 64 + fr, fq * 8), boff = lds_byte(wc * 32 + fr, fq * 8);
#define PG8_ATOFF(pm) ((size_t)((pm) / g.a_tdiv) * (size_t)g.a_thi + (size_t)((pm) % g.a_tdiv) * (size_t)g.a_tlo)
#define PG8_SA(b, h) (((b) * 2 + (h)) * HTB)
#define PG8_SB(b, h) ((4 + (b) * 2 + (h)) * HTB)
#define PG8_STAGE(bufoff, gbase, voff) do { _Pragma("unroll") for (int _i = 0; _i < 2; ++_i) \
        __builtin_amdgcn_global_load_lds((const unsigned*)((const char*)(gbase) + (voff)[_i]), (PG8_LAS unsigned*)(lds + (bufoff) + ldsw + _i * 8192), 16, 0, 0); } while (0)
#define PG8_LDA(dst, b, h) do { _Pragma("unroll") for (int m = 0; m < 4; ++m) _Pragma("unroll") for (int k = 0; k < 2; ++k) dst[m][k] = *(const PG8_LAS bf16x8*)(lds + PG8_SA(b, h) + aoff + m * 2048 + k * 1024); } while (0)
#define PG8_LDB(dst, b, h) do { _Pragma("unroll") for (int n = 0; n < 2; ++n) _Pragma("unroll") for (int k = 0; k < 2; ++k) dst[n][k] = *(const PG8_LAS bf16x8*)(lds + PG8_SB(b, h) + boff + n * 2048 + k * 1024); } while (0)
#define PG8_MMA(ai, bj, At, Bt) do { __builtin_amdgcn_s_setprio(1); _Pragma("unroll") for (int m = 0; m < 4; ++m) _Pragma("unroll") for (int n = 0; n < 2; ++n) _Pragma("unroll") for (int k = 0; k < 2; ++k) \
        acc[ai][bj][m][n] = __builtin_amdgcn_mfma_f32_16x16x32_f16(__builtin_bit_cast(f16x8, Bt[n][k]), __builtin_bit_cast(f16x8, At[m][k]), acc[ai][bj][m][n], 0, 0, 0); __builtin_amdgcn_s_setprio(0); } while (0)
#define PG8_WAIT_V(n) asm volatile("s_waitcnt vmcnt(" #n ")" ::: "memory")
#define PG8_WAIT_L(n) asm volatile("s_waitcnt lgkmcnt(" #n ")" ::: "memory")
#define PG8_BAR __builtin_amdgcn_s_barrier()
#define PG8_SCHED __builtin_amdgcn_sched_barrier(0)
    Unit cur, nxt; int ui = 0;
    if (!S.next(0, cur)) return;
    f32x4 acc[2][2][4][2];
#pragma unroll
    for (int a = 0; a < 2; ++a)
#pragma unroll
        for (int b = 0; b < 2; ++b)
#pragma unroll
            for (int m = 0; m < 4; ++m)
#pragma unroll
                for (int n = 0; n < 2; ++n) acc[a][b][m][n] = (f32x4){0.f, 0.f, 0.f, 0.f};
    bf16x8 At[4][2], B0[2][2], B1[2][2];
    const char* cA = g.A + PG8_ATOFF(cur.pm); const char* cB = g.Bt + (size_t)cur.pn * tstepB;
    S.a_ready(cur);
    if constexpr (SP2) {
        PG8_STAGE(PG8_SB(0, 0), cB, voffB); PG8_STAGE(PG8_SB(0, 1), cB + hstepB, voffB); PG8_STAGE(PG8_SA(0, 0), cA, voffA); PG8_STAGE(PG8_SA(0, 1), cA + hstepA, voffA);
        if (wr == 1) PG8_BAR;
        PG8_WAIT_V(2); PG8_BAR;
        PG8_STAGE(PG8_SB(1, 0), cB + kstepB, voffB); PG8_STAGE(PG8_SA(1, 0), cA + k1A, voffA); PG8_STAGE(PG8_SB(1, 1), cB + hstepB + kstepB, voffB);
        PG8_WAIT_V(6); PG8_BAR;
    } else {
        PG8_STAGE(PG8_SB(0, 0), cB, voffB); PG8_STAGE(PG8_SA(0, 0), cA, voffA); PG8_STAGE(PG8_SB(0, 1), cB + hstepB, voffB); PG8_STAGE(PG8_SA(0, 1), cA + hstepA, voffA);
        if (wr == 1) PG8_BAR;
        PG8_WAIT_V(4); PG8_BAR;
        PG8_STAGE(PG8_SB(1, 0), cB + kstepB, voffB); PG8_STAGE(PG8_SA(1, 0), cA + k1A, voffA); PG8_STAGE(PG8_SB(1, 1), cB + hstepB + kstepB, voffB);
        PG8_WAIT_V(6); PG8_BAR;
    }
    for (;;) {
        const bool has_next = S.next(ui + 1, nxt);
        const char* nA = has_next ? g.A + PG8_ATOFF(nxt.pm) : cA; const char* nB = has_next ? g.Bt + (size_t)nxt.pn * tstepB : cB;
        for (int t = 0; t < nt; t += 2) {
            const bool last = (t == nt - 2);
            const char* aT = cA + (size_t)(t >> 1) * k2A;
            const char* a1 = aT + k1A;
            const char* a2 = last ? nA : aT + k2A; const char* b2 = last ? nB : cB + (size_t)(t + 2) * kstepB;
            const char* a3 = a2 + k1A; const char* b3 = b2 + kstepB;
            if (last && has_next) S.a_ready(nxt);
            if constexpr (SP2) {
            PG8_LDB(B0, 0, 0); PG8_LDB(B1, 0, 1); PG8_SCHED; PG8_LDA(At, 0, 0); PG8_STAGE(PG8_SA(1, 1), a1 + hstepA, voffA);
            PG8_WAIT_V(8); PG8_WAIT_L(0); PG8_BAR; PG8_MMA(0, 0, At, B0); PG8_MMA(0, 1, At, B1); PG8_BAR; PG8_SCHED;
            PG8_LDA(At, 0, 1); PG8_STAGE(PG8_SB(0, 0), b2, voffB); PG8_STAGE(PG8_SB(0, 1), b2 + hstepB, voffB); PG8_STAGE(PG8_SA(0, 0), a2, voffA);
            PG8_WAIT_V(8); PG8_WAIT_L(0); PG8_BAR; PG8_MMA(1, 0, At, B0); PG8_MMA(1, 1, At, B1); PG8_BAR; PG8_SCHED;
            PG8_LDB(B0, 1, 0); PG8_LDB(B1, 1, 1); PG8_SCHED; PG8_LDA(At, 1, 0); PG8_STAGE(PG8_SA(0, 1), a2 + hstepA, voffA);
            PG8_WAIT_V(8); PG8_WAIT_L(0); PG8_BAR; PG8_MMA(0, 0, At, B0); PG8_MMA(0, 1, At, B1); PG8_BAR; PG8_SCHED;
            PG8_LDA(At, 1, 1); PG8_STAGE(PG8_SB(1, 0), b3, voffB); PG8_STAGE(PG8_SB(1, 1), b3 + hstepB, voffB); PG8_STAGE(PG8_SA(1, 0), a3, voffA);
            PG8_WAIT_V(8); PG8_WAIT_L(0); PG8_BAR; PG8_MMA(1, 0, At, B0); PG8_MMA(1, 1, At, B1); PG8_BAR; PG8_SCHED;
            } else {
            PG8_LDB(B0, 0, 0); PG8_SCHED; PG8_LDA(At, 0, 0); PG8_STAGE(PG8_SA(1, 1), a1 + hstepA, voffA);
            PG8_WAIT_L(8); PG8_BAR; PG8_WAIT_L(0); PG8_MMA(0, 0, At, B0); PG8_BAR; PG8_SCHED;
            PG8_LDB(B1, 0, 1); PG8_STAGE(PG8_SB(0, 0), b2, voffB);
            PG8_BAR; PG8_WAIT_L(0); PG8_MMA(0, 1, At, B1); PG8_BAR;
            PG8_LDA(At, 0, 1); PG8_STAGE(PG8_SA(0, 0), a2, voffA);
            PG8_BAR; PG8_WAIT_L(0); PG8_MMA(1, 0, At, B0); PG8_BAR; PG8_SCHED;
            PG8_STAGE(PG8_SB(0, 1), b2 + hstepB, voffB);
            PG8_WAIT_V(6); PG8_BAR; PG8_MMA(1, 1, At, B1); PG8_BAR;
            PG8_LDB(B0, 1, 0); PG8_SCHED; PG8_LDA(At, 1, 0); PG8_STAGE(PG8_SA(0, 1), a2 + hstepA, voffA);
            PG8_WAIT_L(8); PG8_BAR; PG8_WAIT_L(0); PG8_MMA(0, 0, At, B0); PG8_BAR; PG8_SCHED;
            PG8_LDB(B1, 1, 1); PG8_STAGE(PG8_SB(1, 0), b3, voffB);
            PG8_BAR; PG8_WAIT_L(0); PG8_MMA(0, 1, At, B1); PG8_BAR;
            PG8_LDA(At, 1, 1); PG8_STAGE(PG8_SA(1, 0), a3, voffA);
            PG8_BAR; PG8_WAIT_L(0); PG8_MMA(1, 0, At, B0); PG8_BAR; PG8_SCHED;
            PG8_STAGE(PG8_SB(1, 1), b3 + hstepB, voffB);
            PG8_WAIT_V(6); PG8_BAR; PG8_MMA(1, 1, At, B1); PG8_BAR;
            }
        }
        if constexpr (ALIGN_EPI) { if (wr == 0) PG8_BAR; }
        if constexpr (!Epi::AFTER_DRAIN) { E(acc, cur, wr, wc, fr, fq); S.done(cur); }
        if (!has_next) break;
#pragma unroll
        for (int a = 0; a < 2; ++a)
#pragma unroll
            for (int b = 0; b < 2; ++b)
#pragma unroll
                for (int m = 0; m < 4; ++m)
#pragma unroll
                    for (int n = 0; n < 2; ++n) acc[a][b][m][n] = (f32x4){0.f, 0.f, 0.f, 0.f};
        cur = nxt; cA = nA; cB = nB; ++ui;
        if constexpr (ALIGN_EPI) { if (wr == 1) PG8_BAR; }
    }
    PG8_WAIT_V(0);
    if constexpr (!ALIGN_EPI) { if (wr == 0) PG8_BAR; }
    PG8_BAR;
    if constexpr (Epi::AFTER_DRAIN) { E.fused(acc, cur, wr, wc, fr, fq, lds, wid, lane); S.done(cur); }
#undef PG8_ATOFF
#undef PG8_SA
#undef PG8_SB
#undef PG8_STAGE
#undef PG8_LDA
#undef PG8_LDB
#undef PG8_MMA
#undef PG8_WAIT_V
#undef PG8_WAIT_L
#undef PG8_BAR
#undef PG8_SCHED
}
}

constexpr int NWAVES = 8;
constexpr int BATCH = 2, T = 8192, D = 1024, E = 2048, CTX = 256, NH = 16, HD = 128;
constexpr int M = BATCH * T;
constexpr int MC = BATCH * CTX;
constexpr int HPH = 8;
constexpr int NINH = 5 * HPH * HD;
constexpr float EPS = 1e-6f;
constexpr int N_PHASES = 13;

constexpr size_t MiB = 1u << 20, KiB = 1u << 10;
constexpr size_t WS_CTL = 0, CTL_ZERO_BYTES = 256 * KiB;
constexpr size_t WS_MOD = 256 * KiB;
constexpr size_t WS_LB = 320 * KiB;
constexpr size_t WS_F128 = 384 * KiB;
constexpr size_t WS_G64 = 448 * KiB;
constexpr size_t WS_FCT = 512 * KiB;
constexpr size_t WS_TWC = 768 * KiB, WS_TWS = 800 * KiB;
constexpr size_t WS_DVEC = 1 * MiB;
constexpr size_t WS_XCH = 1536 * KiB;
constexpr size_t WS_FTOUT = 3 * MiB;
constexpr size_t WS_WIN = 7 * MiB;
constexpr size_t WS_WOUT = 27 * MiB;
constexpr size_t WS_H0C = 31 * MiB;
constexpr size_t WS_H0 = 32 * MiB;
constexpr size_t WS_Q = 64 * MiB;
constexpr size_t WS_GF = 128 * MiB, WS_GB = 160 * MiB, WS_V = 192 * MiB, WS_Z = 224 * MiB;
constexpr size_t WS_H1P = 128 * MiB;
constexpr size_t WS_UT = 192 * MiB;
constexpr size_t WS_BP1 = 128 * MiB;
constexpr size_t WS_Y1 = 192 * MiB;
constexpr size_t WS_END = 256 * MiB;
constexpr size_t O_PST = 0;
constexpr size_t O_CTXS = 32 * MiB;
constexpr size_t O_FTIN = 40 * MiB;
constexpr size_t O_SCTX = 48 * MiB;
constexpr size_t O_BP0 = 0;

constexpr int CW_TMO = 0, CW_CODE = 1, CW_BAR = 4096;

constexpr int RING_OFF = 0, RING_BYTES = 131072;
constexpr int LDS_BYTES = 163840;
constexpr int MISC_OFF = LDS_BYTES - 256;
constexpr int STAB_OFF = 135168;

#define GAS __attribute__((address_space(1)))
#define LAS __attribute__((address_space(3)))
typedef unsigned short h16;
typedef unsigned v4u __attribute__((ext_vector_type(4)));
typedef unsigned v2u __attribute__((ext_vector_type(2)));
typedef float f32x4 __attribute__((ext_vector_type(4)));
typedef float f32x2 __attribute__((ext_vector_type(2)));
typedef _Float16 hf2 __attribute__((ext_vector_type(2)));
typedef GAS unsigned gu32;
#define RLX_AGENT __ATOMIC_RELAXED, __HIP_MEMORY_SCOPE_AGENT
#define LDS_WAIT() asm volatile("s_waitcnt lgkmcnt(0)" ::: "memory")
#define VM_WAIT() asm volatile("s_waitcnt vmcnt(0)" ::: "memory")
__device__ __forceinline__ h16 f2h(float f) { _Float16 h = (_Float16)f; return __builtin_bit_cast(h16, h); }
__device__ __forceinline__ float h2f(h16 u) { return (float)__builtin_bit_cast(_Float16, u); }
__device__ __forceinline__ unsigned pk2h(float lo, float hi) { f32x2 v = {lo, hi}; hf2 h = __builtin_convertvector(v, hf2); return __builtin_bit_cast(unsigned, h); }
__device__ __forceinline__ float silu_f(float x) { return x / (1.f + __expf(-x)); }
__device__ __forceinline__ float sigmoid_f(float x) { return 1.f / (1.f + __expf(-x)); }

#define XB_TMO      128
#define XB_XCNT(j)  (256  + 64 * (j))
#define XB_XSUB(j)  (1280 + 64 * (j))
#define XB_XGEN(j)  (2304 + 64 * (j))
#define XB_TOP      3328
#define XB_TOPGEN   3392
#define XCD_BAR_WORDS 3456
#define XB_SPIN_CAP (1u << 18)
__device__ __forceinline__ unsigned xb_ld(unsigned* p)              { return __hip_atomic_load(p, __ATOMIC_RELAXED, __HIP_MEMORY_SCOPE_AGENT); }
__device__ __forceinline__ unsigned xb_add(unsigned* p, unsigned v) { return __hip_atomic_fetch_add(p, v, __ATOMIC_RELAXED, __HIP_MEMORY_SCOPE_AGENT); }
__device__ __forceinline__ unsigned xb_xcc_id() { return (unsigned)__builtin_amdgcn_s_getreg((3 << 11) | 20) & 0xFu; }
#define XB_SPIN(cond, bar) do { unsigned _sp = 0; while (cond) { __builtin_amdgcn_s_sleep(1); \
    if ((++_sp & 255u) == 0u) { if (xb_ld(&(bar)[XB_TMO])) break; if (_sp > XB_SPIN_CAP) { atomicAdd(&(bar)[XB_TMO], 1u); break; } } } } while (0)
struct XcdBarrier { unsigned* bar; unsigned x; volatile LAS unsigned* st; };
__device__ __forceinline__ XcdBarrier xcd_barrier_post(unsigned* bar, volatile LAS unsigned* st) {
    XcdBarrier b; b.bar = bar; b.x = xb_xcc_id(); b.st = st;
    if (threadIdx.x == 0) (void)xb_add(&bar[XB_XCNT(b.x)], 1u);
    return b;
}
__device__ __forceinline__ void xcd_barrier_complete(unsigned* bar, unsigned x, unsigned& nloc, unsigned& nx) {
    const unsigned G = gridDim.x * gridDim.y * gridDim.z;
    unsigned sum, cnt, mine, sp = 0u;
    for (;;) {
        sum = 0u; cnt = 0u; mine = 0u;
#pragma unroll
        for (unsigned j = 0; j < 16; ++j) { const unsigned c = xb_ld(&bar[XB_XCNT(j)]); sum += c; cnt += (c > 0u) ? 1u : 0u; mine = (j == x) ? c : mine; }
        if (sum == G) break;
        __builtin_amdgcn_s_sleep(1);
        if ((++sp & 255u) == 0u) { if (xb_ld(&bar[XB_TMO])) break; if (sp > XB_SPIN_CAP) { atomicAdd(&bar[XB_TMO], 1u); break; } }
    }
    nloc = mine > 0u ? mine : 1u; nx = cnt > 0u ? cnt : 1u;
}
__device__ __forceinline__ void xcd_barrier(const XcdBarrier& b) {
    asm volatile("s_waitcnt vmcnt(0)" ::: "memory");
    __syncthreads();
    if (threadIdx.x == 0) {
        unsigned* bar = b.bar;
        __builtin_amdgcn_s_waitcnt(0);
        unsigned nloc = b.st[0], nx = b.st[1];
        if (nloc == 0u) { xcd_barrier_complete(bar, b.x, nloc, nx); b.st[0] = nloc; b.st[1] = nx; }
        const unsigned old = xb_add(&bar[XB_XSUB(b.x)], 1u);
        const unsigned gen = old / nloc;
        if (old + 1u == (gen + 1u) * nloc) {
            __builtin_amdgcn_fence(__ATOMIC_RELEASE, "agent");
            asm volatile("s_waitcnt vmcnt(0)" ::: "memory");
            const unsigned og = xb_add(&bar[XB_TOP], 1u);
            const unsigned tg = og / nx;
            if (og + 1u == (tg + 1u) * nx) xb_add(&bar[XB_TOPGEN], 1u);
            else XB_SPIN(xb_ld(&bar[XB_TOPGEN]) == tg, bar);
            __builtin_amdgcn_fence(__ATOMIC_ACQUIRE, "agent");
            xb_add(&bar[XB_XGEN(b.x)], 1u);
            asm volatile("s_waitcnt vmcnt(0)" ::: "memory");
        } else {
            XB_SPIN(xb_ld(&bar[XB_XGEN(b.x)]) == gen, bar);
            __builtin_amdgcn_fence(__ATOMIC_ACQUIRE, "agent");
            asm volatile("s_waitcnt vmcnt(0)" ::: "memory");
        }
    }
    __syncthreads();
}

struct Frame {
    LAS unsigned char* lds;
    volatile LAS unsigned* MISC;
    gu32* ctl;
    int tid, lane, wave;
    int vcu, G;
    const float *x, *c, *ctx, *c_ctx, *ada_w, *ada_b, *norm_g, *hg_w_in, *hg_lb, *hg_ng, *hg_w_out, *ft_w_in, *ft_w_out, *final_g;
    unsigned char* ws; unsigned char* o;
};

__device__ __forceinline__ int my_lane() { unsigned z = 0u; asm volatile("" : "+v"(z)); return (int)__builtin_amdgcn_mbcnt_hi(~0u, __builtin_amdgcn_mbcnt_lo(~0u, z)); }
__device__ __forceinline__ float wave_sum(float v) {
#pragma unroll
    for (int o = 1; o < 64; o <<= 1) v += __shfl_xor(v, o);
    return v;
}

__device__ __forceinline__ void p0_transpose_item(const float* W, int K, int N, int k0, int n0, h16* WT, int out_row0, LAS float* scr, int lane) {
#pragma unroll 8
    for (int i = 0; i < 32; ++i) { const int kk = 2 * i + (lane >> 5); scr[kk * 33 + (lane & 31)] = W[(size_t)(k0 + kk) * N + n0 + (lane & 31)]; }
    LDS_WAIT(); asm volatile("" ::: "memory");
    const int c = lane & 7;
#pragma unroll
    for (int j = 0; j < 4; ++j) { const int n = (lane >> 3) + 8 * j; const LAS float* s = scr + (8 * c) * 33 + n;
        v4u o; o.x = pk2h(s[0 * 33], s[1 * 33]); o.y = pk2h(s[2 * 33], s[3 * 33]); o.z = pk2h(s[4 * 33], s[5 * 33]); o.w = pk2h(s[6 * 33], s[7 * 33]);
        *(GAS v4u*)(WT + (size_t)(out_row0 + n) * K + k0 + 8 * c) = o; }
    LDS_WAIT(); asm volatile("" ::: "memory");
}
__device__ __forceinline__ void p0_prologue(Frame& F) {
    {
        LAS float* red = (LAS float*)(F.lds + RING_OFF);
        LAS float* sc = (LAS float*)(F.lds + RING_OFF + 8192);
        bool have = false;
        for (int it = F.vcu; it < 192; it += F.G) {
            if (!have) {
                for (int k = F.tid; k < 3 * D; k += NWAVES * 64) { const int v = k / D, kk = k % D; const float cv = (v == 0) ? F.c[kk] : (v == 1) ? F.c[D + kk] : F.c_ctx[kk]; sc[k] = silu_f(cv); }
                __syncthreads(); have = true;
            }
            const int i = it / 96, n0 = (it % 96) * 32, nl = F.tid & 31, kg = F.tid >> 5;
            const float* W = F.ada_w + (size_t)i * D * 3 * D + n0 + nl;
            float a0 = 0.f, a1 = 0.f, a2 = 0.f;
#pragma unroll 16
            for (int k = kg * 64; k < kg * 64 + 64; ++k) { const float w = W[(size_t)k * (3 * D)]; a0 += sc[k] * w; a1 += sc[D + k] * w; a2 += sc[2 * D + k] * w; }
            red[(kg * 3 + 0) * 32 + nl] = a0; red[(kg * 3 + 1) * 32 + nl] = a1; red[(kg * 3 + 2) * 32 + nl] = a2;
            __syncthreads();
            if (F.tid < 96) { const int v = F.tid >> 5, n = F.tid & 31; float s = 0.f;
#pragma unroll
                for (int q = 0; q < 16; ++q) s += red[(q * 3 + v) * 32 + n];
                s += F.ada_b[i * 3 * D + n0 + n];
                float* mod = (float*)(F.ws + WS_MOD);
                if (i == 0) mod[v * 3 * D + n0 + n] = s; else if (v < 2) mod[(3 + v) * 3 * D + n0 + n] = s; }
            __syncthreads();
        }
        __syncthreads();
    }
    const int gw = F.vcu * NWAVES + F.wave, NGW = F.G * NWAVES;
    const int gt = gw * 64 + F.lane, NGT = NGW * 64;
    {
        float* lbv = (float*)(F.ws + WS_LB);
        for (int i = gt; i < 2 * E; i += NGT) { const float l0 = F.hg_lb[i], l1 = F.hg_lb[2 * E + i]; lbv[i] = 1.f / (1.f + __expf(l1 - l0)); }
        h16* f128 = (h16*)(F.ws + WS_F128);
        for (int i = gt; i < 256 * 128; i += NGT) { const int r = i >> 7, n1 = i & 127, k1 = r & 127; float s, c; sincospif(2.f * (float)((k1 * n1) & 127) / 128.f, &s, &c);
            const float v = (r < 128 ? c : -s) * 0.08838834764831845f; f128[i] = f2h(v); }
        h16* g64 = (h16*)(F.ws + WS_G64);
        for (int i = gt; i < 128 * 128; i += NGT) { const int r = i >> 7, cc = i & 127, k2 = r & 63, n2 = cc & 63; float s, c; sincospif(2.f * (float)((k2 * n2) & 63) / 64.f, &s, &c);
            float v; if (r < 64) v = (cc < 64) ? c : s; else v = (cc < 64) ? -s : c; g64[i] = f2h(v * 0.125f); }
        h16* fct = (h16*)(F.ws + WS_FCT);
        for (int i = gt; i < 256 * 512; i += NGT) { const int m = i >> 9, cc = i & 511, j = cc & 255; float s, c; sincospif(2.f * (float)((j * m) & 255) / 256.f, &s, &c);
            fct[i] = f2h((cc < 256 ? c : s) * 0.0625f); }
        float* twc = (float*)(F.ws + WS_TWC); float* tws = (float*)(F.ws + WS_TWS);
        for (int i = gt; i < 128 * 64; i += NGT) { const int k1 = i >> 6, n2 = i & 63; float s, c; sincospif(2.f * (float)(k1 * n2) / 8192.f, &s, &c); twc[i] = c; tws[i] = s; }
    }
    {
        LAS float* scr = (LAS float*)(F.lds + RING_OFF + F.wave * 16384);
        constexpr int I_IN = (D / 64) * (5 * E / 32), I_OUT = (E / 64) * (D / 32), I_FI = (D / 64) * (2 * E / 32), I_FO = (E / 64) * (D / 32);
        constexpr int NITEMS = I_IN + I_OUT + I_FI + I_FO;
        for (int it = gw; it < NITEMS; it += NGW) {
            int r = it;
            if (r < I_IN) { const int nblk = 5 * E / 32, kb = r / nblk, nb = r % nblk, n0 = nb * 32; const int s = n0 / E, h = (n0 % E) / HD, d0 = n0 % HD;
                const int rho = (h / HPH) * NINH + s * (HPH * HD) + (h % HPH) * HD + d0;
                p0_transpose_item(F.hg_w_in, D, 5 * E, kb * 64, n0, (h16*)(F.ws + WS_WIN), rho, scr, F.lane); continue; } r -= I_IN;
            if (r < I_OUT) { const int nblk = D / 32, kb = r / nblk, nb = r % nblk; p0_transpose_item(F.hg_w_out, E, D, kb * 64, nb * 32, (h16*)(F.ws + WS_WOUT), nb * 32, scr, F.lane); continue; } r -= I_OUT;
            if (r < I_FI) { const int nblk = 2 * E / 32, kb = r / nblk, nb = r % nblk; p0_transpose_item(F.ft_w_in, D, 2 * E, kb * 64, nb * 32, (h16*)(F.o + O_FTIN), nb * 32, scr, F.lane); continue; } r -= I_FI;
            { const int nblk = D / 32, kb = r / nblk, nb = r % nblk; p0_transpose_item(F.ft_w_out, E, D, kb * 64, nb * 32, (h16*)(F.ws + WS_FTOUT), nb * 32, scr, F.lane); }
        }
    }
}

__device__ __forceinline__ void modnorm_row(const f32x4 (&v)[4], const float* g, const float* sh, const float* scl, h16* orow, int lane) {
    float s2 = 0.f;
#pragma unroll
    for (int j = 0; j < 4; ++j) s2 += (v[j].x * v[j].x + v[j].y * v[j].y) + (v[j].z * v[j].z + v[j].w * v[j].w);
    const float rstd = 1.f / sqrtf(wave_sum(s2) * (1.f / D) + EPS);
    GAS v2u* o8 = (GAS v2u*)orow + lane;
#pragma unroll
    for (int j = 0; j < 4; ++j) {
        const f32x4 gg = *((const GAS f32x4*)g + lane + 64 * j), ss = *((const GAS f32x4*)sh + lane + 64 * j), cc = *((const GAS f32x4*)scl + lane + 64 * j);
        const f32x4 h = v[j] * rstd * gg * (cc + 1.f) + ss;
        v2u w; w.x = pk2h(h.x, h.y); w.y = pk2h(h.z, h.w); o8[64 * j] = w;
    }
}
__device__ __forceinline__ void p_norm0(Frame& F) {
    const int gw = F.vcu * NWAVES + F.wave, NGW = F.G * NWAVES;
    const float* mod = (const float*)(F.ws + WS_MOD);
    for (int m = gw; m < M + MC; m += NGW) {
        const float* xrow; h16* orow; int mv;
        if (m < M) { xrow = F.x + (size_t)m * D; orow = (h16*)(F.ws + WS_H0) + (size_t)m * D; mv = m >> 13; }
        else { const int mc = m - M; xrow = F.ctx + (size_t)mc * D; orow = (h16*)(F.ws + WS_H0C) + (size_t)mc * D; mv = 2; }
        f32x4 v[4];
#pragma unroll
        for (int j = 0; j < 4; ++j) v[j] = *((const GAS f32x4*)xrow + F.lane + 64 * j);
        modnorm_row(v, F.norm_g, mod + mv * 3 * D, mod + mv * 3 * D + D, orow, F.lane);
    }
}
__device__ __forceinline__ void p_norm1(Frame& F) {
    const int gw = F.vcu * NWAVES + F.wave, NGW = F.G * NWAVES;
    const float* mod = (const float*)(F.ws + WS_MOD);
    for (int m = gw; m < M; m += NGW) {
        const int b = m >> 13, t = m & (T - 1), rp = (t & 63) * 128 + (t >> 6);
        const float* xrow = F.x + (size_t)m * D; const h16* drow = (const h16*)(F.ws + WS_H0) + (size_t)m * D;
        h16* orow = (h16*)(F.ws + WS_H1P) + (size_t)(b * T + rp) * D;
        f32x4 v[4];
#pragma unroll
        for (int j = 0; j < 4; ++j) { v[j] = *((const GAS f32x4*)xrow + F.lane + 64 * j); const v2u dd = *((const GAS v2u*)drow + F.lane + 64 * j);
            v[j].x += h2f((h16)(dd.x & 0xffff)); v[j].y += h2f((h16)(dd.x >> 16)); v[j].z += h2f((h16)(dd.y & 0xffff)); v[j].w += h2f((h16)(dd.y >> 16)); }
        modnorm_row(v, F.norm_g + D, mod + (3 + b) * 3 * D, mod + (3 + b) * 3 * D + D, orow, F.lane);
    }
}
__device__ __forceinline__ void p_final(Frame& F) {
    const int gw = F.vcu * NWAVES + F.wave, NGW = F.G * NWAVES;
    for (int m = gw; m < M; m += NGW) {
        const float* xrow = F.x + (size_t)m * D; const h16* drow = (const h16*)(F.ws + WS_H0) + (size_t)m * D; float* orow = (float*)F.o + (size_t)m * D;
        f32x4 v[4]; float s2 = 0.f;
#pragma unroll
        for (int j = 0; j < 4; ++j) { v[j] = *((const GAS f32x4*)xrow + F.lane + 64 * j) + *((const GAS f32x4*)orow + F.lane + 64 * j); const v2u dd = *((const GAS v2u*)drow + F.lane + 64 * j);
            v[j].x += h2f((h16)(dd.x & 0xffff)); v[j].y += h2f((h16)(dd.x >> 16)); v[j].z += h2f((h16)(dd.y & 0xffff)); v[j].w += h2f((h16)(dd.y >> 16));
            s2 += (v[j].x * v[j].x + v[j].y * v[j].y) + (v[j].z * v[j].z + v[j].w * v[j].w); }
        const float rstd = 1.f / sqrtf(wave_sum(s2) * (1.f / D) + EPS);
#pragma unroll
        for (int j = 0; j < 4; ++j) { const f32x4 gg = *((const GAS f32x4*)F.final_g + F.lane + 64 * j); *((GAS f32x4*)orow + F.lane + 64 * j) = v[j] * rstd * gg; }
    }
}

struct EpiInProj0 {
    unsigned char* ws; unsigned char* o; const float* lbv; int half;
    __device__ __forceinline__ void operator()(int row, int col, const f32x4& a) const {
        const int s = col >> 10, hl = (col >> 7) & 7, d = col & 127;
        const bool isctx = row < MC;
        int b, t; if (isctx) { b = row >> 8; t = row & 255; } else { const int m = row - MC; b = m >> 13; t = m & (T - 1); }
        float r[4];
        if (s == 0 || s == 4) { if (isctx) return;
#pragma unroll
            for (int j = 0; j < 4; ++j) r[j] = silu_f(a[j]); }
        else if (s == 3) {
#pragma unroll
            for (int j = 0; j < 4; ++j) r[j] = a[j]; }
        else { const float* lb = lbv + (s - 1) * E + (half * HPH + hl) * HD + d;
#pragma unroll
            for (int j = 0; j < 4; ++j) { const float l = lb[j]; const float f = l + (1.f - l) * sigmoid_f(a[j]); r[j] = __logf(f); } }
        v2u w; w.x = pk2h(r[0], r[1]); w.y = pk2h(r[2], r[3]);
        h16* dst;
        if (isctx) dst = (h16*)(o + O_CTXS) + ((size_t)((half * 3 + (s - 1)) * BATCH + b) * HPH + hl) * (CTX * HD) + (size_t)t * HD + d;
        else if (s == 0) dst = (h16*)(ws + WS_Q) + ((size_t)(b * NH + half * HPH + hl) * T + t) * HD + d;
        else { const size_t base = (s == 1) ? WS_GF : (s == 2) ? WS_GB : (s == 3) ? WS_V : WS_Z; dst = (h16*)(ws + base) + ((size_t)(b * HPH + hl) * T + t) * HD + d; }
        *(GAS v2u*)dst = w;
    }
};
struct EpiOut0 {
    unsigned char* ws; const float* mod;
    __device__ __forceinline__ void operator()(int row, int col, const f32x4& a) const {
        const int b = row >> 13; const f32x4 gt = *(const GAS f32x4*)(mod + b * 3 * D + 2 * D + col);
        v2u w; w.x = pk2h(a[0] * gt[0], a[1] * gt[1]); w.y = pk2h(a[2] * gt[2], a[3] * gt[3]);
        *(GAS v2u*)((h16*)(ws + WS_H0) + (size_t)row * D + col) = w;
    }
};
struct EpiU {
    unsigned char* ws;
    __device__ __forceinline__ void operator()(int row, int col, const f32x4& a) const {
        const int b = col >> 13, rp = col & (T - 1);
        v2u w; w.x = pk2h(a[0], a[1]); w.y = pk2h(a[2], a[3]);
        *(GAS v2u*)((h16*)(ws + WS_UT) + ((size_t)(b * E + row) * T + rp)) = w;
    }
};
struct EpiZ {
    unsigned char* ws;
    __device__ __forceinline__ void operator()(int row, int col, const f32x4& a) const {
        const int b = row >> 13, rp = row & (T - 1), t = 64 * (rp & 127) + (rp >> 7);
        v2u w; w.x = pk2h(silu_f(a[0]), silu_f(a[1])); w.y = pk2h(silu_f(a[2]), silu_f(a[3]));
        *(GAS v2u*)((h16*)(ws + WS_Q) + ((size_t)(b * T + t) * E + col)) = w;
    }
};
struct EpiOut1 {
    unsigned char* o; const float* mod;
    __device__ __forceinline__ void operator()(int row, int col, const f32x4& a) const {
        const int b = row >> 13; const f32x4 gt = *(const GAS f32x4*)(mod + (3 + b) * 3 * D + 2 * D + col);
        *(GAS f32x4*)((float*)o + (size_t)row * D + col) = a * gt;
    }
};

__device__ __forceinline__ void p_scan_simple(Frame& F, int half) {
    LAS float* qs = (LAS float*)(F.lds + RING_OFF);
    LAS float* fs = qs + 1024; LAS float* ks = fs + 1024; LAS float* vs = ks + 1024;
    LAS float* op = vs + 1024;
    LAS float* red = op + 4096;
    const int dv = F.tid & 127, cq = F.tid >> 7;
    for (int it = F.vcu; it < BATCH * HPH; it += F.G) {
        const int b = it / HPH, hl = it % HPH, h = half * HPH + hl;
        h16* qb = (h16*)(F.ws + WS_Q) + (size_t)(b * NH + h) * T * HD;
        h16* vb = (h16*)(F.ws + WS_V) + (size_t)(b * HPH + hl) * T * HD;
        h16* zb = (h16*)(F.ws + WS_Z) + (size_t)(b * HPH + hl) * T * HD;
        h16* gbb = (h16*)(F.ws + WS_GB) + (size_t)(b * HPH + hl) * T * HD;
        const float ng = F.hg_ng[dv];
        for (int dir = 1; dir >= 0; --dir) {
            h16* gl = (h16*)(F.ws + (dir ? WS_GB : WS_GF)) + (size_t)(b * HPH + hl) * T * HD;
            const h16* gc = (const h16*)(F.o + O_CTXS) + ((size_t)((half * 3 + dir) * BATCH + b) * HPH + hl) * (CTX * HD);
            const h16* vc = (const h16*)(F.o + O_CTXS) + ((size_t)((half * 3 + 2) * BATCH + b) * HPH + hl) * (CTX * HD);
            float S[32];
#pragma unroll
            for (int i = 0; i < 32; ++i) S[i] = 0.f;
            const int nblk = (CTX + T) / 8;
            for (int bi = 0; bi < nblk; ++bi) {
                const bool isctx = bi < CTX / 8;
                const int bl = isctx ? bi : bi - CTX / 8, nb = isctx ? CTX / 8 : T / 8;
                const int t0 = (dir ? (nb - 1 - bl) : bl) * 8;
#pragma unroll
                for (int e = 0; e < 2; ++e) { const int idx = F.tid + e * 512, off = t0 * HD + idx;
                    const float g = h2f(isctx ? gc[off] : gl[off]); const float f = __expf(g);
                    fs[idx] = f; ks[idx] = 1.f - f; vs[idx] = h2f(isctx ? vc[off] : vb[off]); qs[idx] = isctx ? 0.f : h2f(qb[off]); }
                __syncthreads();
#pragma unroll 1
                for (int j = 0; j < 8; ++j) { const int jj = dir ? 7 - j : j; const float vv = vs[jj * 128 + dv]; float po = 0.f;
#pragma unroll
                    for (int i = 0; i < 32; ++i) { const int c = cq * 32 + i; S[i] = fs[jj * 128 + c] * S[i] + ks[jj * 128 + c] * vv; po += S[i] * qs[jj * 128 + c]; }
                    op[(jj * 4 + cq) * 128 + dv] = po; }
                __syncthreads();
                if (!isctx) {
                    float ov[2];
#pragma unroll
                    for (int e = 0; e < 2; ++e) { const int jj = (F.tid >> 7) + 4 * e; ov[e] = (op[(jj * 4 + 0) * 128 + dv] + op[(jj * 4 + 1) * 128 + dv]) + (op[(jj * 4 + 2) * 128 + dv] + op[(jj * 4 + 3) * 128 + dv]); }
                    if (dir == 1) {
#pragma unroll
                        for (int e = 0; e < 2; ++e) { const int jj = (F.tid >> 7) + 4 * e; gbb[(size_t)(t0 + jj) * HD + dv] = f2h(ov[e]); }
                    } else {
#pragma unroll
                        for (int e = 0; e < 2; ++e) { const int jj = (F.tid >> 7) + 4 * e; ov[e] += h2f(gbb[(size_t)(t0 + jj) * HD + dv]);
                            const float ss = wave_sum(ov[e] * ov[e]); if (F.lane == 0) red[jj * 2 + (F.wave & 1)] = ss; }
                        __syncthreads();
#pragma unroll
                        for (int e = 0; e < 2; ++e) { const int jj = (F.tid >> 7) + 4 * e; const float rstd = 1.f / sqrtf((red[jj * 2] + red[jj * 2 + 1]) * (1.f / HD) + EPS);
                            const float y = ov[e] * rstd * ng * h2f(zb[(size_t)(t0 + jj) * HD + dv]); qb[(size_t)(t0 + jj) * HD + dv] = f2h(y); }
                    }
                }
                __syncthreads();
            }
        }
    }
}

typedef short v4s __attribute__((ext_vector_type(4)));
typedef __bf16 bf2_t __attribute__((ext_vector_type(2)));
using pg8::bf16x8; using pg8::f16x8;
constexpr int NSEG = 16, SEGC = 8, CH = 64;
__device__ __forceinline__ unsigned pk2bf(float lo, float hi) { f32x2 v = {lo, hi}; bf2_t b = __builtin_convertvector(v, bf2_t); return __builtin_bit_cast(unsigned, b); }
__device__ __forceinline__ int img_off(int row, int ch) { return 256 * row + 16 * (ch ^ (((row & 3) << 2) | ((row >> 2) & 3))); }
__device__ __forceinline__ bf16x8 row_frag(const LAS unsigned char* img, int rb, int s, int lane) {
    return *(const LAS bf16x8*)(img + img_off((lane & 15) + 16 * rb, 4 * s + (lane >> 4)));
}
__device__ __forceinline__ bf16x8 tr_frag(const LAS unsigned char* img, int c, int ks, int lane) {
    const int g = lane >> 4, q = (lane & 15) >> 2, p = lane & 3;
    const int a0 = img_off(32 * ks + 8 * g + q, 2 * c + (p >> 1)) + 8 * (p & 1);
    const int a1 = img_off(32 * ks + 8 * g + 4 + q, 2 * c + (p >> 1)) + 8 * (p & 1);
    const v4s lo = __builtin_bit_cast(v4s, __builtin_amdgcn_ds_read_tr16_b64_v4i16((LAS v4s*)(img + a0)));
    const v4s hi = __builtin_bit_cast(v4s, __builtin_amdgcn_ds_read_tr16_b64_v4i16((LAS v4s*)(img + a1)));
    return (bf16x8){lo[0], lo[1], lo[2], lo[3], hi[0], hi[1], hi[2], hi[3]};
}
__device__ __forceinline__ float h_lo(unsigned u) { return h2f((h16)(u & 0xffff)); }
__device__ __forceinline__ float h_hi(unsigned u) { return h2f((h16)(u >> 16)); }
__device__ __forceinline__ float* pst_ptr(Frame& F, int dir, int b, int hl, int seg) { return (float*)(F.o + O_PST) + ((size_t)(((dir * BATCH + b) * HPH + hl) * NSEG + seg) << 14); }
__device__ __forceinline__ float* sctx_ptr(Frame& F, int dir, int b, int hl) { return (float*)(F.o + O_SCTX) + ((size_t)((dir * BATCH + b) * HPH + hl) << 14); }
__device__ __forceinline__ float* dvec_ptr(Frame& F, int dir, int b, int hl, int seg) { return (float*)(F.ws + WS_DVEC) + (size_t)((((dir * BATCH + b) * HPH + hl) * NSEG + seg) << 7); }
__device__ __forceinline__ void st_store(float* P, const f32x4 (&St)[8], int w, int fr, int fq) {
#pragma unroll
    for (int ct = 0; ct < 8; ++ct)
#pragma unroll
        for (int r = 0; r < 4; ++r) P[(16 * w + 4 * fq + r) * 128 + 16 * ct + fr] = St[ct][r];
}
__device__ __forceinline__ void st_load(const float* P, f32x4 (&St)[8], int w, int fr, int fq) {
#pragma unroll
    for (int ct = 0; ct < 8; ++ct)
#pragma unroll
        for (int r = 0; r < 4; ++r) St[ct][r] = P[(16 * w + 4 * fq + r) * 128 + 16 * ct + fr];
}

__device__ __forceinline__ void p1_run(Frame& F, const unsigned char* base, unsigned gf, unsigned gb, unsigned vv, int nch, f32x4 (&Pf)[8], f32x4 (&Pb)[8], float (&totf)[2], float (&rhead)[2]) {
    LAS unsigned char* lds = F.lds;
    constexpr int KF = 0, KB = 16384, VI = 32768, TOTF = 49152, TOTB = 53248, DCH = 57344;
    const int tid = F.tid, w = F.wave, cp = tid & 63, tg = tid >> 6;
    LAS float* totF = (LAS float*)(lds + TOTF); LAS float* totB = (LAS float*)(lds + TOTB); LAS float* dch = (LAS float*)(lds + DCH);
    unsigned ugf[8], ugb[8], uv[8];
#define P1_LD(off) (*(const GAS unsigned*)(base + (size_t)(unsigned)(off)))
    { const unsigned tb = (unsigned)((tg * 8) * HD + 2 * cp) * 2u;
#pragma unroll
      for (int i = 0; i < 8; ++i) { ugf[i] = P1_LD(gf + tb + i * HD * 2); ugb[i] = P1_LD(gb + tb + i * HD * 2); uv[i] = P1_LD(vv + tb + i * HD * 2); } }
#pragma unroll 1
    for (int ci = 0; ci < nch; ++ci) {
        int lane = F.lane; asm volatile("" : "+v"(lane));
        const int fr = lane & 15;
        float gf0[8], gf1[8], gb0[8], gb1[8]; float sf0 = 0.f, sf1 = 0.f, sb0 = 0.f, sb1 = 0.f;
#pragma unroll
        for (int i = 0; i < 8; ++i) { gf0[i] = h_lo(ugf[i]); gf1[i] = h_hi(ugf[i]); gb0[i] = h_lo(ugb[i]); gb1[i] = h_hi(ugb[i]); sf0 += gf0[i]; sf1 += gf1[i]; sb0 += gb0[i]; sb1 += gb1[i]; }
        *(LAS f32x2*)(totF + tg * 128 + 2 * cp) = (f32x2){sf0, sf1}; *(LAS f32x2*)(totB + tg * 128 + 2 * cp) = (f32x2){sb0, sb1};
        __syncthreads();
        float suf0 = 0.f, suf1 = 0.f, pre0 = rhead[0], pre1 = rhead[1], all_f0 = 0.f, all_f1 = 0.f, all_b0 = 0.f, all_b1 = 0.f;
#pragma unroll
        for (int g2 = 0; g2 < 8; ++g2) { const f32x2 tf = *(const LAS f32x2*)(totF + g2 * 128 + 2 * cp), tbv = *(const LAS f32x2*)(totB + g2 * 128 + 2 * cp);
            all_f0 += tf.x; all_f1 += tf.y; all_b0 += tbv.x; all_b1 += tbv.y;
            if (g2 > tg) { suf0 += tf.x; suf1 += tf.y; } if (g2 < tg) { pre0 += tbv.x; pre1 += tbv.y; } }
        float rs0 = suf0, rs1 = suf1;
        unsigned kfw[8], kbw[8];
#pragma unroll
        for (int i = 7; i >= 0; --i) { const float k0 = (1.f - __expf(gf0[i])) * __expf(rs0), k1 = (1.f - __expf(gf1[i])) * __expf(rs1); kfw[i] = pk2h(k0, k1); rs0 += gf0[i]; rs1 += gf1[i]; }
#pragma unroll
        for (int i = 0; i < 8; ++i) { const float k0 = (1.f - __expf(gb0[i])) * __expf(pre0), k1 = (1.f - __expf(gb1[i])) * __expf(pre1); kbw[i] = pk2h(k0, k1); pre0 += gb0[i]; pre1 += gb1[i]; }
#pragma unroll
        for (int i = 0; i < 8; ++i) { const int o = img_off(tg * 8 + i, cp >> 2) + (cp & 3) * 4;
            *(LAS unsigned*)(lds + KF + o) = kfw[i]; *(LAS unsigned*)(lds + KB + o) = kbw[i]; *(LAS unsigned*)(lds + VI + o) = uv[i]; }
        if (tg == 0) *(LAS f32x2*)(dch + 2 * cp) = (f32x2){__expf(all_f0), __expf(all_f1)};
        totf[0] += all_f0; totf[1] += all_f1; rhead[0] += all_b0; rhead[1] += all_b1;
        if (ci + 1 < nch) { const unsigned tb = (unsigned)(((ci + 1) * CH + tg * 8) * HD + 2 * cp) * 2u;
#pragma unroll
            for (int i = 0; i < 8; ++i) { ugf[i] = P1_LD(gf + tb + i * HD * 2); ugb[i] = P1_LD(gb + tb + i * HD * 2); uv[i] = P1_LD(vv + tb + i * HD * 2); } }
        __syncthreads();
        bf16x8 va[2];
#pragma unroll
        for (int ks = 0; ks < 2; ++ks) va[ks] = tr_frag(lds + VI, w, ks, lane);
#pragma unroll
        for (int ct = 0; ct < 8; ++ct) { const float d = dch[16 * ct + fr]; Pf[ct] = Pf[ct] * d;
#pragma unroll
            for (int ks = 0; ks < 2; ++ks) {
                const bf16x8 kf_ = tr_frag(lds + KF, ct, ks, lane), kb_ = tr_frag(lds + KB, ct, ks, lane);
                Pf[ct] = __builtin_amdgcn_mfma_f32_16x16x32_f16(__builtin_bit_cast(f16x8, va[ks]), __builtin_bit_cast(f16x8, kf_), Pf[ct], 0, 0, 0);
                Pb[ct] = __builtin_amdgcn_mfma_f32_16x16x32_f16(__builtin_bit_cast(f16x8, va[ks]), __builtin_bit_cast(f16x8, kb_), Pb[ct], 0, 0, 0); } }
    }
    __syncthreads();
#undef P1_LD
}
__device__ __forceinline__ void p_scan1(Frame& F, int half) {
    const int w = F.wave, fr = F.lane & 15, fq = F.lane >> 4, cp = F.tid & 63, tg = F.tid >> 6;
    for (int it = F.vcu; it < BATCH * HPH * NSEG; it += F.G) {
        const int b = it / (HPH * NSEG), hl = (it / NSEG) % HPH, seg = it % NSEG;
        f32x4 Pf[8], Pb[8]; float totf[2], rhead[2];
        if (seg == 0) {
#pragma unroll
            for (int ct = 0; ct < 8; ++ct) { Pf[ct] = (f32x4){0.f, 0.f, 0.f, 0.f}; Pb[ct] = (f32x4){0.f, 0.f, 0.f, 0.f}; }
            totf[0] = totf[1] = rhead[0] = rhead[1] = 0.f;
            const unsigned cs = (unsigned)(CTX * HD * 2), o0 = (unsigned)O_CTXS + (unsigned)(((half * 3 + 0) * BATCH + b) * HPH + hl) * cs, o1 = (unsigned)O_CTXS + (unsigned)(((half * 3 + 1) * BATCH + b) * HPH + hl) * cs, o2 = (unsigned)O_CTXS + (unsigned)(((half * 3 + 2) * BATCH + b) * HPH + hl) * cs;
            p1_run(F, F.o, o0, o1, o2, CTX / CH, Pf, Pb, totf, rhead);
            st_store(sctx_ptr(F, 0, b, hl), Pf, w, fr, fq); st_store(sctx_ptr(F, 1, b, hl), Pb, w, fr, fq);
        }
#pragma unroll
        for (int ct = 0; ct < 8; ++ct) { Pf[ct] = (f32x4){0.f, 0.f, 0.f, 0.f}; Pb[ct] = (f32x4){0.f, 0.f, 0.f, 0.f}; }
        totf[0] = totf[1] = rhead[0] = rhead[1] = 0.f;
        const unsigned so = (unsigned)(((b * HPH + hl) * T + seg * SEGC * CH) * HD) * 2u;
        p1_run(F, F.ws, (unsigned)WS_GF + so, (unsigned)WS_GB + so, (unsigned)WS_V + so, SEGC, Pf, Pb, totf, rhead);
        st_store(pst_ptr(F, 0, b, hl, seg), Pf, w, fr, fq); st_store(pst_ptr(F, 1, b, hl, seg), Pb, w, fr, fq);
        if (tg == 0) { *(GAS f32x2*)(dvec_ptr(F, 0, b, hl, seg) + 2 * cp) = (f32x2){__expf(totf[0]), __expf(totf[1])}; *(GAS f32x2*)(dvec_ptr(F, 1, b, hl, seg) + 2 * cp) = (f32x2){__expf(rhead[0]), __expf(rhead[1])}; }
    }
}
__device__ __forceinline__ void p_scan_combine(Frame& F) {
    for (int it = F.vcu; it < 2 * BATCH * HPH * 8; it += F.G) {
        const int sl = it & 7, hl = (it >> 3) % HPH, b = (it >> 3) / HPH % BATCH, dir = (it >> 3) / (HPH * BATCH);
        const int e = sl * 2048 + F.tid * 4, c = e & 127;
        f32x4 tmp[NSEG];
        float* const p0 = pst_ptr(F, dir, b, hl, 0) + e; const float* const d0 = dvec_ptr(F, dir, b, hl, 0) + c;
#pragma unroll
        for (int j = 0; j < NSEG; ++j) tmp[j] = *(const GAS f32x4*)(p0 + ((size_t)j << 14));
        f32x4 Tt = *(const GAS f32x4*)(sctx_ptr(F, dir, b, hl) + e);
#pragma unroll 1
        for (int jj = 0; jj < NSEG; ++jj) { const int j = dir ? NSEG - 1 - jj : jj; const f32x4 dd = *(const GAS f32x4*)(d0 + (j << 7));
            f32x4 tj = tmp[0];
#pragma unroll
            for (int q = 1; q < NSEG; ++q) tj = (q == j) ? tmp[q] : tj;
            *(GAS f32x4*)(p0 + ((size_t)j << 14)) = Tt; Tt = Tt * dd + tj; }
    }
}
template <int DIR> __device__ __forceinline__ void p2_sweep(Frame& F, unsigned qb, unsigned gb_, unsigned vb, unsigned zb, unsigned pb, f32x4 (&St)[8], bool dummy = false) {
    unsigned char* const wsb = F.ws;
#define P2_U32(off) (*(const GAS unsigned*)(wsb + (size_t)(unsigned)(off)))
#define P2_V4(off) (*(GAS v4u*)(wsb + (size_t)(unsigned)(off)))
    LAS unsigned char* lds = F.lds;
    constexpr int QI = 0, KI = 16384, VI = 32768, AI = 49152, SI = 65536, OB = 98304, TOT = 132096, EB = 136192, E2 = 136704;
    const int tid = F.tid, w = F.wave, cp = tid & 63, tg = tid >> 6;
    LAS float* tot = (LAS float*)(lds + TOT); LAS float* eb = (LAS float*)(lds + EB); LAS float* e2 = (LAS float*)(lds + E2); LAS float* ob = (LAS float*)(lds + OB);
    const int ft = tid >> 3, fj = tid & 7;
    unsigned uq[8], ug[8], uv[8];
    { const unsigned tb = (unsigned)(((DIR ? SEGC - 1 : 0) * CH + tg * 8) * HD + 2 * cp) * 2u;
#pragma unroll
      for (int i = 0; i < 8; ++i) { uq[i] = P2_U32(qb + tb + i * HD * 2); ug[i] = P2_U32(gb_ + tb + i * HD * 2); uv[i] = P2_U32(vb + tb + i * HD * 2); } }
#pragma unroll 1
    for (int step = 0; step < SEGC; ++step) {
        int lane = F.lane; asm volatile("" : "+v"(lane));
        const int fr = lane & 15, fq = lane >> 4;
        const int ci = DIR ? SEGC - 1 - step : step;
        const unsigned co = (unsigned)(ci * CH * HD) * 2u;
        float g0[8], g1[8]; float s0 = 0.f, s1 = 0.f;
#pragma unroll
        for (int i = 0; i < 8; ++i) { g0[i] = h_lo(ug[i]); g1[i] = h_hi(ug[i]); s0 += g0[i]; s1 += g1[i]; }
        *(LAS f32x2*)(tot + tg * 128 + 2 * cp) = (f32x2){s0, s1};
        v4u p0, p1, z0, z1;
        if (DIR == 1) { const unsigned fo = co + (unsigned)(ft * HD + 16 * fj) * 2u;
            p0 = P2_V4(pb + fo); p1 = P2_V4(pb + fo + 16); z0 = P2_V4(zb + fo); z1 = P2_V4(zb + fo + 16); }
        __syncthreads();
        float pre0 = 0.f, pre1 = 0.f, be0 = 0.f, be1 = 0.f, al0 = 0.f, al1 = 0.f;
#pragma unroll
        for (int g2 = 0; g2 < 8; ++g2) { const f32x2 tv = *(const LAS f32x2*)(tot + g2 * 128 + 2 * cp); al0 += tv.x; al1 += tv.y;
            if (DIR == 0) { if (g2 < tg) { pre0 += tv.x; pre1 += tv.y; } if (g2 < 4) { be0 += tv.x; be1 += tv.y; } }
            else { if (g2 > tg) { pre0 += tv.x; pre1 += tv.y; } if (g2 >= 4) { be0 += tv.x; be1 += tv.y; } } }
        {
            float r0 = pre0, r1 = pre1;
#pragma unroll
            for (int ii = 0; ii < 8; ++ii) { const int i = DIR ? 7 - ii : ii;
                r0 += g0[i]; r1 += g1[i];
                const float e0 = __expf(r0 - be0), e1 = __expf(r1 - be1), i0 = __expf(be0 - r0), i1 = __expf(be1 - r1);
                const float k0 = 1.f - __expf(g0[i]), k1 = 1.f - __expf(g1[i]);
                const int o = img_off(tg * 8 + i, cp >> 2) + (cp & 3) * 4;
                *(LAS unsigned*)(lds + QI + o) = pk2bf(h_lo(uq[i]) * e0, h_hi(uq[i]) * e1);
                *(LAS unsigned*)(lds + KI + o) = pk2bf(k0 * i0, k1 * i1);
                *(LAS unsigned*)(lds + VI + o) = pk2bf(h_lo(uv[i]), h_hi(uv[i])); }
        }
        if (tg == 0) { *(LAS f32x2*)(eb + 2 * cp) = (f32x2){__expf(be0), __expf(be1)}; *(LAS f32x2*)(e2 + 2 * cp) = (f32x2){__expf(al0 - be0), __expf(al1 - be1)}; }
        if (step + 1 < SEGC) { const unsigned tb = (unsigned)(((DIR ? ci - 1 : ci + 1) * CH + tg * 8) * HD + 2 * cp) * 2u;
#pragma unroll
            for (int i = 0; i < 8; ++i) { uq[i] = P2_U32(qb + tb + i * HD * 2); ug[i] = P2_U32(gb_ + tb + i * HD * 2); uv[i] = P2_U32(vb + tb + i * HD * 2); } }
        __syncthreads();
#pragma unroll
        for (int ct = 0; ct < 8; ++ct) { St[ct] = St[ct] * eb[16 * ct + fr];
            v2u wv; wv.x = pk2bf(St[ct][0], St[ct][1]); wv.y = pk2bf(St[ct][2], St[ct][3]);
            *(LAS v2u*)(lds + SI + img_off(16 * ct + fr, 2 * w + (fq >> 1)) + (fq & 1) * 8) = wv; }
        {
            const int ti = w >> 1;
            f32x4 sc[2] = {(f32x4){0.f, 0.f, 0.f, 0.f}, (f32x4){0.f, 0.f, 0.f, 0.f}};
#pragma unroll
            for (int ks = 0; ks < 4; ++ks) { const bf16x8 qf = row_frag(lds + QI, ti, ks, lane);
#pragma unroll
                for (int u = 0; u < 2; ++u) { const bf16x8 kf = row_frag(lds + KI, 2 * (w & 1) + u, ks, lane); sc[u] = __builtin_amdgcn_mfma_f32_16x16x32_bf16(kf, qf, sc[u], 0, 0, 0); } }
#pragma unroll
            for (int u = 0; u < 2; ++u) { const int sj = 2 * (w & 1) + u, t = 16 * ti + fr; float m[4];
#pragma unroll
                for (int r = 0; r < 4; ++r) { const int sidx = 16 * sj + 4 * fq + r; const bool keep = DIR ? (sidx >= t) : (sidx <= t); m[r] = keep ? sc[u][r] : 0.f; }
                v2u wv; wv.x = pk2bf(m[0], m[1]); wv.y = pk2bf(m[2], m[3]);
                *(LAS v2u*)(lds + AI + img_off(t, 2 * sj + (fq >> 1)) + (fq & 1) * 8) = wv; }
        }
        __syncthreads();
        f32x4 oacc[4];
#pragma unroll
        for (int ti = 0; ti < 4; ++ti) oacc[ti] = (f32x4){0.f, 0.f, 0.f, 0.f};
        bf16x8 va[2];
#pragma unroll
        for (int ks = 0; ks < 2; ++ks) { va[ks] = tr_frag(lds + VI, w, ks, lane);
#pragma unroll
            for (int ti = 0; ti < 4; ++ti) { const bf16x8 af = row_frag(lds + AI, ti, ks, lane); oacc[ti] = __builtin_amdgcn_mfma_f32_16x16x32_bf16(va[ks], af, oacc[ti], 0, 0, 0); } }
#pragma unroll
        for (int ks = 0; ks < 4; ++ks) { const bf16x8 sf = tr_frag(lds + SI, w, ks, lane);
#pragma unroll
            for (int ti = 0; ti < 4; ++ti) { const bf16x8 qf = row_frag(lds + QI, ti, ks, lane); oacc[ti] = __builtin_amdgcn_mfma_f32_16x16x32_bf16(sf, qf, oacc[ti], 0, 0, 0); } }
#pragma unroll
        for (int ct = 0; ct < 8; ++ct) {
#pragma unroll
            for (int ks = 0; ks < 2; ++ks) { const bf16x8 kf = tr_frag(lds + KI, ct, ks, lane); St[ct] = __builtin_amdgcn_mfma_f32_16x16x32_bf16(va[ks], kf, St[ct], 0, 0, 0); }
            St[ct] = St[ct] * e2[16 * ct + fr]; }
#pragma unroll
        for (int ti = 0; ti < 4; ++ti) *(LAS f32x4*)(ob + (16 * ti + fr) * 132 + 16 * w + 4 * fq) = oacc[ti];
        __syncthreads();
        {
            f32x4 ov[4];
#pragma unroll
            for (int i = 0; i < 4; ++i) ov[i] = *(const LAS f32x4*)(ob + ft * 132 + 16 * fj + 4 * i);
            const unsigned fo = co + (unsigned)(ft * HD + 16 * fj) * 2u;
            const unsigned dmy = (unsigned)(WS_XCH) + (unsigned)(blockIdx.x & 7) * (unsigned)(SEGC * CH * HD * 2);
            if (DIR == 0) {
                v4u w0, w1; w0.x = pk2h(ov[0][0], ov[0][1]); w0.y = pk2h(ov[0][2], ov[0][3]); w0.z = pk2h(ov[1][0], ov[1][1]); w0.w = pk2h(ov[1][2], ov[1][3]);
                w1.x = pk2h(ov[2][0], ov[2][1]); w1.y = pk2h(ov[2][2], ov[2][3]); w1.z = pk2h(ov[3][0], ov[3][1]); w1.w = pk2h(ov[3][2], ov[3][3]);
                const unsigned dst = (dummy ? dmy : pb) + fo; P2_V4(dst) = w0; P2_V4(dst + 16) = w1;
            } else {
                const unsigned pu[8] = {p0.x, p0.y, p0.z, p0.w, p1.x, p1.y, p1.z, p1.w}, zu[8] = {z0.x, z0.y, z0.z, z0.w, z1.x, z1.y, z1.z, z1.w};
                float o16[16]; float ss = 0.f;
#pragma unroll
                for (int i = 0; i < 8; ++i) { o16[2 * i] = ov[i >> 1][(2 * i) & 3] + h_lo(pu[i]); o16[2 * i + 1] = ov[i >> 1][(2 * i + 1) & 3] + h_hi(pu[i]); ss += o16[2 * i] * o16[2 * i] + o16[2 * i + 1] * o16[2 * i + 1]; }
                ss += __shfl_xor(ss, 1); ss += __shfl_xor(ss, 2); ss += __shfl_xor(ss, 4);
                const float rstd = 1.f / sqrtf(ss * (1.f / HD) + EPS);
                unsigned yo[8];
#pragma unroll
                for (int i = 0; i < 8; ++i) { const f32x2 ng = *(const GAS f32x2*)(F.hg_ng + 16 * fj + 2 * i);
                    yo[i] = pk2h(o16[2 * i] * rstd * ng.x * h_lo(zu[i]), o16[2 * i + 1] * rstd * ng.y * h_hi(zu[i])); }
                const unsigned dst = (dummy ? dmy : qb) + fo; P2_V4(dst) = (v4u){yo[0], yo[1], yo[2], yo[3]}; P2_V4(dst + 16) = (v4u){yo[4], yo[5], yo[6], yo[7]};
            }
        }
    }
    __syncthreads();
#undef P2_U32
#undef P2_V4
}
__device__ __forceinline__ void p_scan2(Frame& F, int half, bool dummy = false) {
    const int w = F.wave, fr = F.lane & 15, fq = F.lane >> 4;
    for (int it = F.vcu; it < BATCH * HPH * NSEG; it += F.G) {
        const int b = it / (HPH * NSEG), hl = (it / NSEG) % HPH, seg = it % NSEG, h = half * HPH + hl;
        const unsigned qb = (unsigned)WS_Q + (unsigned)(((b * NH + h) * T + seg * SEGC * CH) * HD) * 2u;
        const unsigned so = (unsigned)(((b * HPH + hl) * T + seg * SEGC * CH) * HD) * 2u;
        const unsigned gfb = (unsigned)WS_GF + so, gbb = (unsigned)WS_GB + so, vb = (unsigned)WS_V + so, zb = (unsigned)WS_Z + so;
        f32x4 St[8];
        st_load(pst_ptr(F, 0, b, hl, seg), St, w, fr, fq);
        p2_sweep<0>(F, qb, gfb, vb, zb, gfb, St, dummy);
        st_load(pst_ptr(F, 1, b, hl, seg), St, w, fr, fq);
        p2_sweep<1>(F, qb, gbb, vb, zb, gfb, St, dummy);
    }
}

__device__ __forceinline__ h16* bp_ptr(Frame& F, int b) { return (h16*)(b == 0 ? F.o + O_BP0 : F.ws + WS_BP1); }
__device__ __forceinline__ void p_fftA_simple(Frame& F) {
    LAS float* us = (LAS float*)(F.lds + RING_OFF);
    LAS float* tc = us + 8192; LAS float* ts = tc + 128;
    if (F.tid < 128) { float s, c; sincospif(2.f * (float)F.tid / 128.f, &s, &c); tc[F.tid] = c; ts[F.tid] = s; }
    const float* twc = (const float*)(F.ws + WS_TWC); const float* tws = (const float*)(F.ws + WS_TWS);
    for (int it = F.vcu; it < BATCH * E; it += F.G) {
        const int b = it / E, ch = it % E;
        const h16* u = (const h16*)(F.ws + WS_UT) + (size_t)(b * E + ch) * T;
        __syncthreads();
        for (int i = F.tid; i < T; i += NWAVES * 64) us[i] = h2f(u[i]);
        __syncthreads();
        const int k1 = F.tid & 127, ng = F.tid >> 7;
        h16* bp = bp_ptr(F, b) + ((size_t)k1 * E + ch) * 128;
        for (int q = 0; q < 16; ++q) { const int n2 = ng * 16 + q; float ar = 0.f, ai = 0.f;
            for (int n1 = 0; n1 < 128; ++n1) { const float uv = us[n2 * 128 + n1]; const int ix = (n1 * k1) & 127; ar += uv * tc[ix]; ai -= uv * ts[ix]; }
            ar *= 0.08838834764831845f; ai *= 0.08838834764831845f;
            const float c = twc[k1 * 64 + n2], s = tws[k1 * 64 + n2];
            bp[n2] = f2h(ar * c + ai * s); bp[64 + n2] = f2h(ai * c - ar * s); }
    }
}
__device__ __forceinline__ void p_fftBC_simple(Frame& F) {
    LAS h16* bt = (LAS h16*)(F.lds + RING_OFF);
    LAS h16* vt = (LAS h16*)(F.lds + RING_OFF + 65536);
    LAS float* t64 = (LAS float*)(F.lds + STAB_OFF);
    LAS float* t256 = t64 + 128;
    if (F.tid < 64) { float s, c; sincospif(2.f * (float)F.tid / 64.f, &s, &c); t64[F.tid] = c; t64[64 + F.tid] = s; }
    if (F.tid < 256) { float s, c; sincospif(2.f * (float)F.tid / 256.f, &s, &c); t256[F.tid] = c; t256[256 + F.tid] = s; }
    for (int it = F.vcu; it < BATCH * 128 * 8; it += F.G) {
        const int b = it / 1024, k1 = (it % 1024) / 8, g = it % 8;
        const h16* bp = bp_ptr(F, b) + ((size_t)k1 * E + g * 256) * 128;
        __syncthreads();
        for (int i = F.tid; i < 256 * 128; i += NWAVES * 64) { const int cch = i >> 7, n = i & 127; bt[cch * 128 + ((n + 2 * cch) & 127)] = bp[i]; }
        __syncthreads();
        const int ch = F.tid & 255, kh = F.tid >> 8;
        for (int q = 0; q < 32; ++q) { const int k2 = kh * 32 + q; float ar = 0.f, ai = 0.f;
            for (int n2 = 0; n2 < 64; ++n2) { const float br = h2f(bt[ch * 128 + ((n2 + 2 * ch) & 127)]), bi = h2f(bt[ch * 128 + ((64 + n2 + 2 * ch) & 127)]); const int ix = (n2 * k2) & 63; const float c = t64[ix], s = t64[64 + ix];
                ar += br * c + bi * s; ai += bi * c - br * s; }
            vt[(k2 * 256 + ch) * 2] = f2h(ar * 0.125f); vt[(k2 * 256 + ch) * 2 + 1] = f2h(ai * 0.125f); }
        __syncthreads();
        const int m = ch;
        for (int q = 0; q < 32; ++q) { const int k2 = kh * 32 + q; float a = 0.f;
            for (int j = 0; j < 256; ++j) { const int ix = (j * m) & 255; a += h2f(vt[(k2 * 256 + j) * 2]) * t256[ix] + h2f(vt[(k2 * 256 + j) * 2 + 1]) * t256[256 + ix]; }
            const size_t idx = (size_t)(b * T + k1 + 128 * k2) * E + g * 256 + m;
            const float zz = h2f(((const h16*)(F.ws + WS_Q))[idx]);
            ((h16*)(F.ws + WS_Y1))[idx] = f2h(a * 0.0625f * zz); }
    }
}

struct EpiFftA {
    static constexpr bool PERM = false, AFTER_DRAIN = false;
    unsigned char* ws; unsigned char* o;
    __device__ __forceinline__ void operator()(const pg8::f32x4 (&acc)[2][2][4][2], const pg8::Unit& u, int wr, int wc, int fr, int fq) const {
        asm volatile("" : "+v"(fr), "+v"(fq));
        const unsigned char* twc = ws + WS_TWC; const unsigned char* tws = ws + WS_TWS;
        const int b = u.pn >> 9, ch0 = (u.pn & 511) * 4;
        unsigned char* bp = (b == 0 ? o + O_BP0 : ws + WS_BP1);
#pragma unroll
        for (int m = 0; m < 4; ++m) {
            const unsigned k1 = (unsigned)(wr * 64 + m * 16 + fr);
#pragma unroll
            for (int bj = 0; bj < 2; ++bj)
#pragma unroll
                for (int n = 0; n < 2; ++n) {
                    const unsigned cl = (unsigned)(bj * 128 + wc * 32 + n * 16 + fq * 4), ch = (unsigned)ch0 + (cl >> 6), n2 = cl & 63u;
                    const unsigned toff = (k1 * 64u + n2) * 4u;
                    const f32x4 c4 = *(const GAS f32x4*)(twc + (size_t)toff), s4 = *(const GAS f32x4*)(tws + (size_t)toff);
                    const f32x4 re = acc[0][bj][m][n], im = acc[1][bj][m][n];
                    const f32x4 orr = re * c4 + im * s4, oi = im * c4 - re * s4;
                    const unsigned doff = ((k1 * (unsigned)E + ch) * 128u + n2) * 2u;
                    v2u w0; w0.x = pk2h(orr[0], orr[1]); w0.y = pk2h(orr[2], orr[3]);
                    v2u w1; w1.x = pk2h(oi[0], oi[1]); w1.y = pk2h(oi[2], oi[3]);
                    *(GAS v2u*)(bp + (size_t)doff) = w0; *(GAS v2u*)(bp + (size_t)doff + 128) = w1;
                    asm volatile("" ::: "memory"); __builtin_amdgcn_sched_barrier(0);
                }
        }
    }
};

__device__ __forceinline__ void bc_stage_half(LAS unsigned char* lds, int ldsoff, const char* gbase, int rs, int tid, int wid) {
#pragma unroll
    for (int i = 0; i < 2; ++i) { int R, C; pg8::stage_rc(tid * 16 + i * 8192, R, C);
        __builtin_amdgcn_global_load_lds((const unsigned*)(gbase + (size_t)R * rs + C * 2), (LAS unsigned*)(lds + ldsoff + wid * 1024 + i * 8192), 16, 0, 0); }
}
__device__ __forceinline__ void p_fftBC(Frame& F) {
    using pg8::f16x8; using pg8::bf16x8;
    LAS unsigned char* lds = F.lds + RING_OFF;
    const int tid = F.tid, wid = F.wave;
    const int rh = wid >> 2, rb = (wid * 32) & 127;
    const char* FCT = (const char*)(F.ws + WS_FCT);
    constexpr int GR = 0, XO = 32768, FB = 98304;
#define BC_WAITV(n) asm volatile("s_waitcnt vmcnt(" #n ")" ::: "memory")
#define BC_BAR() do { asm volatile("s_waitcnt lgkmcnt(0)" ::: "memory"); __builtin_amdgcn_s_barrier(); asm volatile("" ::: "memory"); } while (0)
    unsigned fsrc[2];
#pragma unroll
    for (int i = 0; i < 2; ++i) { const int B = wid * 1024 + i * 8192 + (tid & 63) * 16, row = B >> 6, ch = ((B >> 4) & 3) ^ ((row >> 2) & 3); fsrc[i] = (unsigned)(row * 1024 + ch * 16); }
#define BC_STAGE_F(kt) do { _Pragma("unroll") for (int _i = 0; _i < 2; ++_i) \
        __builtin_amdgcn_global_load_lds((const unsigned*)(FCT + fsrc[_i] + (kt) * 64), (LAS unsigned*)(lds + FB + ((kt) % 3) * 16384 + wid * 1024 + _i * 8192), 16, 0, 0); } while (0)
#define BC_STAGE_BP(bpp) do { _Pragma("unroll") for (int r2 = 0; r2 < 2; ++r2) _Pragma("unroll") for (int kh = 0; kh < 2; ++kh) \
        bc_stage_half(lds, XO + (r2 * 2 + kh) * 16384, (bpp) + (size_t)r2 * 128 * 256 + kh * 128, 256, tid, wid); } while (0)
    int it = F.vcu;
    if (it >= BATCH * 128 * 8) return;
    {
        const char* G = (const char*)(F.ws + WS_G64);
#pragma unroll
        for (int kh = 0; kh < 2; ++kh) bc_stage_half(lds, GR + kh * 16384, G + kh * 128, 256, tid, wid);
        const int b = it >> 10, k1 = (it >> 3) & 127, g = it & 7;
        BC_STAGE_BP((const char*)(bp_ptr(F, b) + ((size_t)k1 * E + g * 256) * 128));
    }
#pragma unroll 1
    for (; it < BATCH * 128 * 8; it += F.G) {
        const int b = it >> 10, k1 = (it >> 3) & 127, g = it & 7;
        int lane = F.lane; asm volatile("" : "+v"(lane));
        const int fr = lane & 15, fq = lane >> 4;
        BC_WAITV(0); BC_BAR();
        BC_STAGE_F(0); BC_STAGE_F(1);
        f32x4 accB[2][8];
#pragma unroll
        for (int mt = 0; mt < 2; ++mt)
#pragma unroll
            for (int nt = 0; nt < 8; ++nt) accB[mt][nt] = (f32x4){0.f, 0.f, 0.f, 0.f};
#pragma unroll
        for (int kh = 0; kh < 2; ++kh)
#pragma unroll
            for (int kk = 0; kk < 2; ++kk) {
                bf16x8 a[2], bb[8];
#pragma unroll
                for (int mt = 0; mt < 2; ++mt) a[mt] = *(const LAS bf16x8*)(lds + XO + (rh * 2 + kh) * 16384 + pg8::lds_byte(rb + 16 * mt + fr, kk * 32 + fq * 8));
#pragma unroll
                for (int nt = 0; nt < 8; ++nt) bb[nt] = *(const LAS bf16x8*)(lds + GR + kh * 16384 + pg8::lds_byte(16 * nt + fr, kk * 32 + fq * 8));
                __builtin_amdgcn_sched_barrier(0);
#pragma unroll
                for (int nt = 0; nt < 8; ++nt)
#pragma unroll
                    for (int mt = 0; mt < 2; ++mt) accB[mt][nt] = __builtin_amdgcn_mfma_f32_16x16x32_f16(__builtin_bit_cast(f16x8, a[mt]), __builtin_bit_cast(f16x8, bb[nt]), accB[mt][nt], 0, 0, 0);
                __builtin_amdgcn_sched_barrier(0);
            }
        v2u zz[2][4];
#pragma unroll
        for (int mt = 0; mt < 2; ++mt)
#pragma unroll
            for (int nt = 0; nt < 4; ++nt) { const int m = wid * 32 + 16 * mt + 4 * fq, k2 = 16 * nt + fr;
                zz[mt][nt] = *(const GAS v2u*)((const h16*)(F.ws + WS_Q) + ((size_t)(b * T + k1 + 128 * k2) * E + g * 256 + m)); }
        BC_BAR();
#pragma unroll
        for (int mt = 0; mt < 2; ++mt)
#pragma unroll
            for (int nt = 0; nt < 8; ++nt) { const int ch = wid * 32 + 16 * mt + 4 * fq, ri = nt >> 2, k2 = (16 * nt + fr) & 63, kb = ri * 4 + (ch >> 6);
                v2u w; w.x = pk2h(accB[mt][nt][0], accB[mt][nt][1]); w.y = pk2h(accB[mt][nt][2], accB[mt][nt][3]);
                *(LAS v2u*)(lds + XO + kb * 8192 + pg8::lds_byte(k2, ch & 63)) = w; }
        f32x4 accC[2][4];
#pragma unroll
        for (int mt = 0; mt < 2; ++mt)
#pragma unroll
            for (int nt = 0; nt < 4; ++nt) accC[mt][nt] = (f32x4){0.f, 0.f, 0.f, 0.f};
#pragma unroll
        for (int kt = 0; kt < 16; ++kt) {
            if (kt < 15) BC_WAITV(2); else BC_WAITV(0);
            BC_BAR();
            if (kt + 2 < 16) BC_STAGE_F(kt + 2);
            bf16x8 a[2], bb[4];
#pragma unroll
            for (int mt = 0; mt < 2; ++mt) { const int row = wid * 32 + 16 * mt + fr; a[mt] = *(const LAS bf16x8*)(lds + FB + (kt % 3) * 16384 + row * 64 + 16 * (fq ^ ((row >> 2) & 3))); }
#pragma unroll
            for (int nt = 0; nt < 4; ++nt) bb[nt] = *(const LAS bf16x8*)(lds + XO + (kt >> 1) * 8192 + pg8::lds_byte(16 * nt + fr, (kt & 1) * 32 + fq * 8));
            __builtin_amdgcn_sched_barrier(0);
#pragma unroll
            for (int nt = 0; nt < 4; ++nt)
#pragma unroll
                for (int mt = 0; mt < 2; ++mt) accC[mt][nt] = __builtin_amdgcn_mfma_f32_16x16x32_f16(__builtin_bit_cast(f16x8, a[mt]), __builtin_bit_cast(f16x8, bb[nt]), accC[mt][nt], 0, 0, 0);
            __builtin_amdgcn_sched_barrier(0);
        }
        v2u wout[2][4];
#pragma unroll
        for (int mt = 0; mt < 2; ++mt)
#pragma unroll
            for (int nt = 0; nt < 4; ++nt) { const v2u zv = zz[mt][nt];
                wout[mt][nt].x = pk2h(accC[mt][nt][0] * h2f((h16)(zv.x & 0xffff)), accC[mt][nt][1] * h2f((h16)(zv.x >> 16)));
                wout[mt][nt].y = pk2h(accC[mt][nt][2] * h2f((h16)(zv.y & 0xffff)), accC[mt][nt][3] * h2f((h16)(zv.y >> 16))); }
        BC_BAR();
        if (it + F.G < BATCH * 128 * 8) { const int it2 = it + F.G, b2 = it2 >> 10, k12 = (it2 >> 3) & 127, g2 = it2 & 7;
            BC_STAGE_BP((const char*)(bp_ptr(F, b2) + ((size_t)k12 * E + g2 * 256) * 128)); }
#pragma unroll
        for (int mt = 0; mt < 2; ++mt)
#pragma unroll
            for (int nt = 0; nt < 4; ++nt) { const int m = wid * 32 + 16 * mt + 4 * fq, k2 = 16 * nt + fr;
                *(GAS v2u*)((h16*)(F.ws + WS_Y1) + ((size_t)(b * T + k1 + 128 * k2) * E + g * 256 + m)) = wout[mt][nt]; }
    }
    BC_WAITV(0); BC_BAR();
#undef BC_WAITV
#undef BC_BAR
#undef BC_STAGE_F
#undef BC_STAGE_BP
}

struct Args { const float* in[14]; float* out; unsigned char* ws; int ph_lo, ph_hi, li, pad; };
__global__ void __launch_bounds__(NWAVES * 64, 2) skel_fwd(Args args) {
    extern __shared__ __attribute__((aligned(16))) unsigned char lds[];
    Frame F;
    F.lds = (LAS unsigned char*)lds;
    F.MISC = (volatile LAS unsigned*)(F.lds + MISC_OFF);
    const int wave_s = __builtin_amdgcn_readfirstlane((int)threadIdx.x >> 6);
    F.tid = threadIdx.x; F.lane = F.tid & 63; F.wave = wave_s;
    F.G = gridDim.x; { const int bx = blockIdx.x; F.vcu = (F.G % 8 == 0) ? (bx % 8) * (F.G / 8) + bx / 8 : bx; }
    F.ws = args.ws; F.o = (unsigned char*)args.out;
    F.ctl = (gu32*)(F.ws + WS_CTL);
    F.x = args.in[0]; F.c = args.in[1]; F.ctx = args.in[2]; F.c_ctx = args.in[3]; F.ada_w = args.in[4]; F.ada_b = args.in[5]; F.norm_g = args.in[6];
    F.hg_w_in = args.in[7]; F.hg_lb = args.in[8]; F.hg_ng = args.in[9]; F.hg_w_out = args.in[10]; F.ft_w_in = args.in[11]; F.ft_w_out = args.in[12]; F.final_g = args.in[13];
    if (F.tid < 32) ((LAS unsigned*)(F.lds + MISC_OFF))[F.tid] = 0u;
    __syncthreads();
    XcdBarrier bar; bar.bar = (unsigned*)(F.ctl + CW_BAR); bar.x = 0; bar.st = nullptr;
    if (MK_N_LAUNCHES == 1) bar = xcd_barrier_post((unsigned*)(F.ctl + CW_BAR), F.MISC + 8);
#define GRID_BAR() do { if (MK_N_LAUNCHES == 1) { xcd_barrier(bar); if ((PROBE_MASK >> 14) & 1) xcd_barrier(bar); } } while (0)
    const int lo = args.ph_lo, hi = args.ph_hi;
#define IN(k) (lo <= (k) && (k) < hi)
#define MYTID() (wave_s * 64 + my_lane())
#define REFRESH() do { int t_ = MYTID(); asm volatile("" : "+v"(t_)); F.tid = t_; F.lane = t_ & 63; F.wave = wave_s; } while (0)
#define BOTH(k) (IN(k) && IN((k) + 1))
    const float* mod = (const float*)(F.ws + WS_MOD);

    if (IN(0)) { for (int rep = 0; rep < 1 + ((PROBE_MASK >> 0) & 1); ++rep) { REFRESH(); p0_prologue(F); } if (BOTH(0)) GRID_BAR(); }
    if (IN(1)) { for (int rep = 0; rep < 1 + ((PROBE_MASK >> 1) & 1); ++rep) { REFRESH(); p_norm0(F); } if (BOTH(1)) GRID_BAR(); }
#pragma unroll 1
    for (int half = 0; half < 2; ++half) {
        if (IN(2 + 2 * half)) for (int rep = 0; rep < 1 + ((PROBE_MASK >> 2) & 1); ++rep) {
            pg8::Gemm g = pg8::make_gemm(F.ws + WS_H0C, F.ws + WS_WIN + (size_t)half * NINH * D * 2, M + MC, NINH, D);
            pg8::StaticOrder S; S.init(M + MC, NINH, F.G, (int)blockIdx.x);
            pg8::EpiElem<EpiInProj0> Ep{EpiInProj0{F.ws, F.o, (const float*)(F.ws + WS_LB), half}};
            pg8::gemm_phase<pg8::EpiElem<EpiInProj0>, pg8::StaticOrder, true, true>(F.lds + RING_OFF, g, S, Ep, MYTID());
            if (rep == ((PROBE_MASK >> 2) & 1) && BOTH(2 + 2 * half)) GRID_BAR();
        }
        if (IN(3 + 2 * half)) {
            REFRESH();
#if SIMPLE_SCAN
            p_scan_simple(F, half);
#else
            for (int rep = 0; rep < 1 + ((PROBE_MASK >> 13) & 1); ++rep) { REFRESH(); p_scan1(F, half); } GRID_BAR(); REFRESH(); p_scan_combine(F); GRID_BAR(); if ((PROBE_MASK >> 15) & 1) { REFRESH(); p_scan2(F, half, true); } REFRESH(); p_scan2(F, half);
#endif
            if (BOTH(3 + 2 * half)) GRID_BAR();
        }
    }
    if (IN(6)) for (int rep = 0; rep < 1 + ((PROBE_MASK >> 6) & 1); ++rep) {
        pg8::Gemm g = pg8::make_gemm(F.ws + WS_Q, F.ws + WS_WOUT, M, D, E);
        g.a_rs = HD * 2; g.a_k1 = 128; g.a_k2 = (long)T * HD * 2; g.a_tdiv = T / 256; g.a_thi = (long)NH * T * HD * 2; g.a_tlo = 256L * HD * 2;
        pg8::StaticOrder S; S.init(M, D, F.G, (int)blockIdx.x);
        pg8::EpiElem<EpiOut0> Ep{EpiOut0{F.ws, mod}};
        pg8::gemm_phase<pg8::EpiElem<EpiOut0>, pg8::StaticOrder, true, true>(F.lds + RING_OFF, g, S, Ep, MYTID());
        if (rep == ((PROBE_MASK >> 6) & 1) && BOTH(6)) GRID_BAR();
    }
    if (IN(7)) { for (int rep = 0; rep < 1 + ((PROBE_MASK >> 7) & 1); ++rep) { REFRESH(); p_norm1(F); } if (BOTH(7)) GRID_BAR(); }
    if (IN(8)) for (int rep = 0; rep < 1 + ((PROBE_MASK >> 8) & 1); ++rep) {
        { pg8::Gemm g = pg8::make_gemm(F.o + O_FTIN, F.ws + WS_H1P, E, M, D);
          pg8::StaticOrder S; S.init(E, M, F.G, (int)blockIdx.x);
          pg8::EpiElem<EpiU> Ep{EpiU{F.ws}};
          pg8::gemm_phase<pg8::EpiElem<EpiU>, pg8::StaticOrder, true, true>(F.lds + RING_OFF, g, S, Ep, MYTID()); }
        __syncthreads();
        { pg8::Gemm g = pg8::make_gemm(F.ws + WS_H1P, F.o + O_FTIN + (size_t)E * D * 2, M, E, D);
          pg8::StaticOrder S; S.init(M, E, F.G, (int)blockIdx.x);
          pg8::EpiElem<EpiZ> Ep{EpiZ{F.ws}};
          pg8::gemm_phase<pg8::EpiElem<EpiZ>, pg8::StaticOrder, true, true>(F.lds + RING_OFF, g, S, Ep, MYTID()); }
        if (rep == ((PROBE_MASK >> 8) & 1) && BOTH(8)) GRID_BAR();
    }
    if (IN(9)) for (int rep = 0; rep < 1 + ((PROBE_MASK >> 9) & 1); ++rep) {
#if SIMPLE_FFTA
        REFRESH(); p_fftA_simple(F);
#else
        int kfa = 128; asm volatile("" : "+s"(kfa));
        pg8::Gemm g = pg8::make_gemm(F.ws + WS_F128, F.ws + WS_UT, 256, BATCH * E * 64, kfa);
        pg8::StaticOrder S; S.init(256, BATCH * E * 64, F.G, (int)blockIdx.x);
        EpiFftA Ep{F.ws, F.o};
        pg8::gemm_phase<EpiFftA, pg8::StaticOrder, true, true>(F.lds + RING_OFF, g, S, Ep, MYTID());
#endif
        if (rep == ((PROBE_MASK >> 9) & 1) && BOTH(9)) GRID_BAR();
    }
    if (IN(10)) for (int rep = 0; rep < 1 + ((PROBE_MASK >> 10) & 1); ++rep) {
        REFRESH();
#if SIMPLE_FFTBC
        p_fftBC_simple(F);
#else
        p_fftBC(F);
#endif
        if (rep == ((PROBE_MASK >> 10) & 1) && BOTH(10)) GRID_BAR();
    }
    if (IN(11)) for (int rep = 0; rep < 1 + ((PROBE_MASK >> 11) & 1); ++rep) {
        pg8::Gemm g = pg8::make_gemm(F.ws + WS_Y1, F.ws + WS_FTOUT, M, D, E);
        pg8::StaticOrder S; S.init(M, D, F.G, (int)blockIdx.x);
        pg8::EpiElem<EpiOut1> Ep{EpiOut1{F.o, mod}};
        pg8::gemm_phase<pg8::EpiElem<EpiOut1>, pg8::StaticOrder, true, true>(F.lds + RING_OFF, g, S, Ep, MYTID());
        if (rep == ((PROBE_MASK >> 11) & 1) && BOTH(11)) GRID_BAR();
    }
    if (IN(12)) { REFRESH(); p_final(F); }
#undef IN
#undef BOTH
}

extern "C" void kernel_launch(void* const* d_in, const int* in_sizes, int n_in, void* d_out, int out_size, void* d_ws, size_t ws_size, hipStream_t stream) {
    static int grid = 0;
    if (grid == 0) {
        if (n_in != 14 || in_sizes[0] != M * D || out_size != M * D || ws_size < WS_END) { fprintf(stderr, "kernel_launch: unexpected shapes (n_in %d, ws %zu)\n", n_in, ws_size); grid = -1; return; }
        int dev = 0, cus = 0, per_cu = 0;
        if (hipGetDevice(&dev) != hipSuccess || hipDeviceGetAttribute(&cus, hipDeviceAttributeMultiprocessorCount, dev) != hipSuccess) { grid = -1; return; }
        if (hipFuncSetAttribute((const void*)skel_fwd, hipFuncAttributeMaxDynamicSharedMemorySize, LDS_BYTES) != hipSuccess) { fprintf(stderr, "kernel_launch: hipFuncSetAttribute failed\n"); grid = -1; return; }
        if (hipOccupancyMaxActiveBlocksPerMultiprocessor(&per_cu, (const void*)skel_fwd, NWAVES * 64, LDS_BYTES) != hipSuccess || per_cu < 1) { fprintf(stderr, "kernel_launch: occupancy query says %d\n", per_cu); per_cu = 1; }
        (void)hipGetLastError();
        grid = cus;
    }
    if (grid < 0) return;
    (void)hipMemsetAsync((char*)d_ws + WS_CTL, 0, CTL_ZERO_BYTES, stream);
    Args a{};
    for (int i = 0; i < 14; ++i) a.in[i] = (const float*)d_in[i];
    a.out = (float*)d_out; a.ws = (unsigned char*)d_ws;
    if (MK_N_LAUNCHES == 1) { a.ph_lo = 0; a.ph_hi = N_PHASES; a.li = 0; hipLaunchKernelGGL(skel_fwd, dim3(grid), dim3(NWAVES * 64), LDS_BYTES, stream, a); }
    else for (int li = 0; li < N_PHASES; ++li) { a.ph_lo = li; a.ph_hi = li + 1; a.li = li; hipLaunchKernelGGL(skel_fwd, dim3(grid), dim3(NWAVES * 64), LDS_BYTES, stream, a); }
}
```

```cpp
#include <hip/hip_runtime.h>
#include <cstdio>
#include <cstdint>

#ifndef SIMPLE_FFTA
#define SIMPLE_FFTA 0
#endif
#ifndef SIMPLE_FFTBC
#define SIMPLE_FFTBC 0
#endif
#ifndef PROBE_MASK
#define PROBE_MASK 0
#endif
#ifndef SIMPLE_SCAN
#define SIMPLE_SCAN 0
#endif
#ifndef MK_N_LAUNCHES
#define MK_N_LAUNCHES 1
#endif

namespace pg8 {
#define PG8_LAS __attribute__((address_space(3)))
typedef unsigned short h16_t;
typedef short bf16x8 __attribute__((ext_vector_type(8)));
typedef _Float16 f16x8 __attribute__((ext_vector_type(8)));
typedef float f32x4 __attribute__((ext_vector_type(4)));
typedef unsigned u32x4 __attribute__((ext_vector_type(4)));
constexpr int BM = 256, BK = 64, HALF = 128, HTB = HALF * BK * 2, STAGE_BYTES = 8 * HTB, NXCD = 8, WGM = 8;

__host__ __device__ __forceinline__ int lds_byte(int r, int c) { const int st = (r >> 4) * 2 + (c >> 5), rr = r & 15, cc = c & 31, ob = rr * 64 + cc * 2; return st * 1024 + (ob ^ (((ob >> 9) & 1) << 5)); }
__host__ __device__ __forceinline__ void stage_rc(int b, int& R, int& C) { const int st = b / 1024, sb = b % 1024, swz = sb ^ (((sb >> 9) & 1) << 5); R = (st >> 1) * 16 + swz / 64; C = (st & 1) * 32 + (swz % 64) / 2; }
__host__ __device__ __forceinline__ int perm32(int rho) { const int n = rho >> 4, i = rho & 15; return 8 * (i >> 2) + 4 * n + (i & 3); }

struct Unit { int pm, pn; };
struct Gemm {
    const char* A; const char* Bt; int M, N, K;
    int a_rs;
    int a_k1;
    long a_k2;
    int a_tdiv; long a_thi, a_tlo;
};
__host__ __device__ __forceinline__ Gemm make_gemm(const void* A, const void* Bt, int M, int N, int K) {
    Gemm g; g.A = (const char*)A; g.Bt = (const char*)Bt; g.M = M; g.N = N; g.K = K; g.a_rs = K * 2; g.a_k1 = BK * 2; g.a_k2 = BK * 4; g.a_tdiv = 1 << 30; g.a_thi = 0; g.a_tlo = (long)BM * K * 2; return g;
}

struct StaticOrder {
    int nM, nN, nwg, G, c;
    __host__ __device__ void init(int M, int N, int G_, int c_) { nM = M / BM; nN = N / BM; nwg = nM * nN; G = G_; c = c_; }
    __host__ __device__ bool next(int i, Unit& u) const {
        const long L = (long)i * G + c; if (L >= nwg) return false;
        int wgid = (int)L; { const int q = nwg / NXCD, r = nwg % NXCD, xcd = wgid % NXCD, off = wgid / NXCD; wgid = (xcd < r ? xcd * (q + 1) : r * (q + 1) + (xcd - r) * q) + off; }
        const int nig = WGM * nN, gid = wgid / nig, fm = gid * WGM, gsz = (nM - fm) < WGM ? (nM - fm) : WGM;
        u.pm = fm + ((wgid % nig) % gsz); u.pn = (wgid % nig) / gsz; return true;
    }
    __device__ __forceinline__ void a_ready(const Unit&) const {}
    __device__ __forceinline__ void done(const Unit&) const {}
};

template <class F> struct EpiElem {
    static constexpr bool PERM = false, AFTER_DRAIN = false;
    F f;
    __device__ __forceinline__ void operator()(const f32x4 (&acc)[2][2][4][2], const Unit& u, int wr, int wc, int fr, int fq) const {
        asm volatile("" : "+v"(fr), "+v"(fq));
#pragma unroll
        for (int ai = 0; ai < 2; ++ai)
#pragma unroll
            for (int m = 0; m < 4; ++m) {
                const int row = u.pm * BM + ai * HALF + wr * 64 + m * 16 + fr;
#pragma unroll
                for (int bj = 0; bj < 2; ++bj)
#pragma unroll
                    for (int n = 0; n < 2; ++n) {
                        const int col = u.pn * BM + bj * HALF + wc * 32 + n * 16 + fq * 4;
                        f(row, col, acc[ai][bj][m][n]);
                    }
            }
    }
};

template <class Epi, class Sched, bool ALIGN_EPI = false, bool SP2 = false>
__device__ __forceinline__ void gemm_phase(PG8_LAS unsigned char* lds, const Gemm g, const Sched& S, const Epi& E, int tid_in) {
    int tid_ = tid_in; asm volatile("" : "+v"(tid_));
    const int tid = tid_, wid = __builtin_amdgcn_readfirstlane(tid >> 6), lane = tid & 63, wr = wid >> 2, wc = wid & 3, fr = lane & 15, fq = lane >> 4;
    const int K = g.K, nt = K / BK;
    unsigned voffA[2], voffB[2];
#pragma unroll
    for (int i = 0; i < 2; ++i) { int R, C; stage_rc(tid * 16 + i * 8192, R, C); const int Rb = Epi::PERM ? ((R & ~31) + perm32(R & 31)) : R;
        voffA[i] = (unsigned)(R * g.a_rs + C * 2); voffB[i] = (unsigned)(Rb * K + C) * 2u; }
    const size_t kstepB = (size_t)(BK * 2);
    const size_t hstepA = (size_t)HALF * g.a_rs, hstepB = (size_t)HALF * K * 2, tstepB = 2 * hstepB;
    const size_t k1A = (size_t)g.a_k1, k2A = (size_t)g.a_k2;
    const unsigned ldsw = (unsigned)wid * 1024u;
    const int aoff = lds_byte(wr * 64 + fr, fq * 8), boff = lds_byte(wc * 32 + fr, fq * 8);
#define PG8_ATOFF(pm) ((size_t)((pm) / g.a_tdiv) * (size_t)g.a_thi + (size_t)((pm) % g.a_tdiv) * (size_t)g.a_tlo)
#define PG8_SA(b, h) (((b) * 2 + (h)) * HTB)
#define PG8_SB(b, h) ((4 + (b) * 2 + (h)) * HTB)
#define PG8_STAGE(bufoff, gbase, voff) do { _Pragma("unroll") for (int _i = 0; _i < 2; ++_i) \
        __builtin_amdgcn_global_load_lds((const unsigned*)((const char*)(gbase) + (voff)[_i]), (PG8_LAS unsigned*)(lds + (bufoff) + ldsw + _i * 8192), 16, 0, 0); } while (0)
#define PG8_LDA(dst, b, h) do { _Pragma("unroll") for (int m = 0; m < 4; ++m) _Pragma("unroll") for (int k = 0; k < 2; ++k) dst[m][k] = *(const PG8_LAS bf16x8*)(lds + PG8_SA(b, h) + aoff + m * 2048 + k * 1024); } while (0)
#define PG8_LDB(dst, b, h) do { _Pragma("unroll") for (int n = 0; n < 2; ++n) _Pragma("unroll") for (int k = 0; k < 2; ++k) dst[n][k] = *(const PG8_LAS bf16x8*)(lds + PG8_SB(b, h) + boff + n * 2048 + k * 1024); } while (0)
#define PG8_MMA(ai, bj, At, Bt) do { __builtin_amdgcn_s_setprio(1); _Pragma("unroll") for (int m = 0; m < 4; ++m) _Pragma("unroll") for (int n = 0; n < 2; ++n) _Pragma("unroll") for (int k = 0; k < 2; ++k) \
        acc[ai][bj][m][n] = __builtin_amdgcn_mfma_f32_16x16x32_f16(__builtin_bit_cast(f16x8, Bt[n][k]), __builtin_bit_cast(f16x8, At[m][k]), acc[ai][bj][m][n], 0, 0, 0); __builtin_amdgcn_s_setprio(0); } while (0)
#define PG8_WAIT_V(n) asm volatile("s_waitcnt vmcnt(" #n ")" ::: "memory")
#define PG8_WAIT_L(n) asm volatile("s_waitcnt lgkmcnt(" #n ")" ::: "memory")
#define PG8_BAR __builtin_amdgcn_s_barrier()
#define PG8_SCHED __builtin_amdgcn_sched_barrier(0)
    Unit cur, nxt; int ui = 0;
    if (!S.next(0, cur)) return;
    f32x4 acc[2][2][4][2];
#pragma unroll
    for (int a = 0; a < 2; ++a)
#pragma unroll
        for (int b = 0; b < 2; ++b)
#pragma unroll
            for (int m = 0; m < 4; ++m)
#pragma unroll
                for (int n = 0; n < 2; ++n) acc[a][b][m][n] = (f32x4){0.f, 0.f, 0.f, 0.f};
    bf16x8 At[4][2], B0[2][2], B1[2][2];
    const char* cA = g.A + PG8_ATOFF(cur.pm); const char* cB = g.Bt + (size_t)cur.pn * tstepB;
    S.a_ready(cur);
    if constexpr (SP2) {
        PG8_STAGE(PG8_SB(0, 0), cB, voffB); PG8_STAGE(PG8_SB(0, 1), cB + hstepB, voffB); PG8_STAGE(PG8_SA(0, 0), cA, voffA); PG8_STAGE(PG8_SA(0, 1), cA + hstepA, voffA);
        if (wr == 1) PG8_BAR;
        PG8_WAIT_V(2); PG8_BAR;
        PG8_STAGE(PG8_SB(1, 0), cB + kstepB, voffB); PG8_STAGE(PG8_SA(1, 0), cA + k1A, voffA); PG8_STAGE(PG8_SB(1, 1), cB + hstepB + kstepB, voffB);
        PG8_WAIT_V(6); PG8_BAR;
    } else {
        PG8_STAGE(PG8_SB(0, 0), cB, voffB); PG8_STAGE(PG8_SA(0, 0), cA, voffA); PG8_STAGE(PG8_SB(0, 1), cB + hstepB, voffB); PG8_STAGE(PG8_SA(0, 1), cA + hstepA, voffA);
        if (wr == 1) PG8_BAR;
        PG8_WAIT_V(4); PG8_BAR;
        PG8_STAGE(PG8_SB(1, 0), cB + kstepB, voffB); PG8_STAGE(PG8_SA(1, 0), cA + k1A, voffA); PG8_STAGE(PG8_SB(1, 1), cB + hstepB + kstepB, voffB);
        PG8_WAIT_V(6); PG8_BAR;
    }
    for (;;) {
        const bool has_next = S.next(ui + 1, nxt);
        const char* nA = has_next ? g.A + PG8_ATOFF(nxt.pm) : cA; const char* nB = has_next ? g.Bt + (size_t)nxt.pn * tstepB : cB;
        for (int t = 0; t < nt; t += 2) {
            const bool last = (t == nt - 2);
            const char* aT = cA + (size_t)(t >> 1) * k2A;
            const char* a1 = aT + k1A;
            const char* a2 = last ? nA : aT + k2A; const char* b2 = last ? nB : cB + (size_t)(t + 2) * kstepB;
            const char* a3 = a2 + k1A; const char* b3 = b2 + kstepB;
            if (last && has_next) S.a_ready(nxt);
            if constexpr (SP2) {
            PG8_LDB(B0, 0, 0); PG8_LDB(B1, 0, 1); PG8_SCHED; PG8_LDA(At, 0, 0); PG8_STAGE(PG8_SA(1, 1), a1 + hstepA, voffA);
            PG8_WAIT_V(8); PG8_WAIT_L(0); PG8_BAR; PG8_MMA(0, 0, At, B0); PG8_MMA(0, 1, At, B1); PG8_BAR; PG8_SCHED;
            PG8_LDA(At, 0, 1); PG8_STAGE(PG8_SB(0, 0), b2, voffB); PG8_STAGE(PG8_SB(0, 1), b2 + hstepB, voffB); PG8_STAGE(PG8_SA(0, 0), a2, voffA);
            PG8_WAIT_V(8); PG8_WAIT_L(0); PG8_BAR; PG8_MMA(1, 0, At, B0); PG8_MMA(1, 1, At, B1); PG8_BAR; PG8_SCHED;
            PG8_LDB(B0, 1, 0); PG8_LDB(B1, 1, 1); PG8_SCHED; PG8_LDA(At, 1, 0); PG8_STAGE(PG8_SA(0, 1), a2 + hstepA, voffA);
            PG8_WAIT_V(8); PG8_WAIT_L(0); PG8_BAR; PG8_MMA(0, 0, At, B0); PG8_MMA(0, 1, At, B1); PG8_BAR; PG8_SCHED;
            PG8_LDA(At, 1, 1); PG8_STAGE(PG8_SB(1, 0), b3, voffB); PG8_STAGE(PG8_SB(1, 1), b3 + hstepB, voffB); PG8_STAGE(PG8_SA(1, 0), a3, voffA);
            PG8_WAIT_V(8); PG8_WAIT_L(0); PG8_BAR; PG8_MMA(1, 0, At, B0); PG8_MMA(1, 1, At, B1); PG8_BAR; PG8_SCHED;
            } else {
            PG8_LDB(B0, 0, 0); PG8_SCHED; PG8_LDA(At, 0, 0); PG8_STAGE(PG8_SA(1, 1), a1 + hstepA, voffA);
            PG8_WAIT_L(8); PG8_BAR; PG8_WAIT_L(0); PG8_MMA(0, 0, At, B0); PG8_BAR; PG8_SCHED;
            PG8_LDB(B1, 0, 1); PG8_STAGE(PG8_SB(0, 0), b2, voffB);
            PG8_BAR; PG8_WAIT_L(0); PG8_MMA(0, 1, At, B1); PG8_BAR;
            PG8_LDA(At, 0, 1); PG8_STAGE(PG8_SA(0, 0), a2, voffA);
            PG8_BAR; PG8_WAIT_L(0); PG8_MMA(1, 0, At, B0); PG8_BAR; PG8_SCHED;
            PG8_STAGE(PG8_SB(0, 1), b2 + hstepB, voffB);
            PG8_WAIT_V(6); PG8_BAR; PG8_MMA(1, 1, At, B1); PG8_BAR;
            PG8_LDB(B0, 1, 0); PG8_SCHED; PG8_LDA(At, 1, 0); PG8_STAGE(PG8_SA(0, 1), a2 + hstepA, voffA);
            PG8_WAIT_L(8); PG8_BAR; PG8_WAIT_L(0); PG8_MMA(0, 0, At, B0); PG8_BAR; PG8_SCHED;
            PG8_LDB(B1, 1, 1); PG8_STAGE(PG8_SB(1, 0), b3, voffB);
            PG8_BAR; PG8_WAIT_L(0); PG8_MMA(0, 1, At, B1); PG8_BAR;
            PG8_LDA(At, 1, 1); PG8_STAGE(PG8_SA(1, 0), a3, voffA);
            PG8_BAR; PG8_WAIT_L(0); PG8_MMA(1, 0, At, B0); PG8_BAR; PG8_SCHED;
            PG8_STAGE(PG8_SB(1, 1), b3 + hstepB, voffB);
            PG8_WAIT_V(6); PG8_BAR; PG8_MMA(1, 1, At, B1); PG8_BAR;
            }
        }
        if constexpr (ALIGN_EPI) { if (wr == 0) PG8_BAR; }
        if constexpr (!Epi::AFTER_DRAIN) { E(acc, cur, wr, wc, fr, fq); if ((PROBE_MASK >> 16) & 1) { asm volatile("" ::: "memory"); E(acc, cur, wr, wc, fr, fq); } S.done(cur); }
        if (!has_next) break;
#pragma unroll
        for (int a = 0; a < 2; ++a)
#pragma unroll
            for (int b = 0; b < 2; ++b)
#pragma unroll
                for (int m = 0; m < 4; ++m)
#pragma unroll
                    for (int n = 0; n < 2; ++n) acc[a][b][m][n] = (f32x4){0.f, 0.f, 0.f, 0.f};
        cur = nxt; cA = nA; cB = nB; ++ui;
        if constexpr (ALIGN_EPI) { if (wr == 1) PG8_BAR; }
    }
    PG8_WAIT_V(0);
    if constexpr (!ALIGN_EPI) { if (wr == 0) PG8_BAR; }
    PG8_BAR;
    if constexpr (Epi::AFTER_DRAIN) { E.fused(acc, cur, wr, wc, fr, fq, lds, wid, lane); S.done(cur); }
#undef PG8_ATOFF
#undef PG8_SA
#undef PG8_SB
#undef PG8_STAGE
#undef PG8_LDA
#undef PG8_LDB
#undef PG8_MMA
#undef PG8_WAIT_V
#undef PG8_WAIT_L
#undef PG8_BAR
#undef PG8_SCHED
}
}

constexpr int NWAVES = 8;
constexpr int BATCH = 2, T = 8192, D = 1024, E = 2048, CTX = 256, NH = 16, HD = 128;
constexpr int M = BATCH * T;
constexpr int MC = BATCH * CTX;
constexpr int HPH = 8;
constexpr int NINH = 5 * HPH * HD;
constexpr float EPS = 1e-6f;
constexpr int N_PHASES = 13;

constexpr size_t MiB = 1u << 20, KiB = 1u << 10;
constexpr size_t WS_CTL = 0, CTL_ZERO_BYTES = 256 * KiB;
constexpr size_t WS_MOD = 256 * KiB;
constexpr size_t WS_LB = 320 * KiB;
constexpr size_t WS_F128 = 384 * KiB;
constexpr size_t WS_G64 = 448 * KiB;
constexpr size_t WS_FCT = 512 * KiB;
constexpr size_t WS_TWC = 768 * KiB, WS_TWS = 800 * KiB;
constexpr size_t WS_DVEC = 1 * MiB;
constexpr size_t WS_XCH = 1536 * KiB;
constexpr size_t WS_FTOUT = 3 * MiB;
constexpr size_t WS_WIN = 7 * MiB;
constexpr size_t WS_WOUT = 27 * MiB;
constexpr size_t WS_H0C = 31 * MiB;
constexpr size_t WS_H0 = 32 * MiB;
constexpr size_t WS_Q = 64 * MiB;
constexpr size_t WS_GF = 128 * MiB, WS_GB = 160 * MiB, WS_V = 192 * MiB, WS_Z = 224 * MiB;
constexpr size_t WS_H1P = 128 * MiB;
constexpr size_t WS_UT = 192 * MiB;
constexpr size_t WS_BP1 = 128 * MiB;
constexpr size_t WS_Y1 = 192 * MiB;
constexpr size_t WS_END = 256 * MiB;
constexpr size_t O_PST = 0;
constexpr size_t O_CTXS = 32 * MiB;
constexpr size_t O_FTIN = 40 * MiB;
constexpr size_t O_SCTX = 48 * MiB;
constexpr size_t O_BP0 = 0;

constexpr int CW_TMO = 0, CW_CODE = 1, CW_BAR = 4096;

constexpr int RING_OFF = 0, RING_BYTES = 131072;
constexpr int LDS_BYTES = 163840;
constexpr int MISC_OFF = LDS_BYTES - 256;
constexpr int STAB_OFF = 135168;

#define GAS __attribute__((address_space(1)))
#define LAS __attribute__((address_space(3)))
typedef unsigned short h16;
typedef unsigned v4u __attribute__((ext_vector_type(4)));
typedef unsigned v2u __attribute__((ext_vector_type(2)));
typedef float f32x4 __attribute__((ext_vector_type(4)));
typedef float f32x2 __attribute__((ext_vector_type(2)));
typedef _Float16 hf2 __attribute__((ext_vector_type(2)));
typedef GAS unsigned gu32;
#define RLX_AGENT __ATOMIC_RELAXED, __HIP_MEMORY_SCOPE_AGENT
#define LDS_WAIT() asm volatile("s_waitcnt lgkmcnt(0)" ::: "memory")
#define VM_WAIT() asm volatile("s_waitcnt vmcnt(0)" ::: "memory")
__device__ __forceinline__ h16 f2h(float f) { _Float16 h = (_Float16)f; return __builtin_bit_cast(h16, h); }
__device__ __forceinline__ float h2f(h16 u) { return (float)__builtin_bit_cast(_Float16, u); }
__device__ __forceinline__ unsigned pk2h(float lo, float hi) { f32x2 v = {lo, hi}; hf2 h = __builtin_convertvector(v, hf2); return __builtin_bit_cast(unsigned, h); }
__device__ __forceinline__ float silu_f(float x) { return x / (1.f + __expf(-x)); }
__device__ __forceinline__ float sigmoid_f(float x) { return 1.f / (1.f + __expf(-x)); }

#define XB_TMO      128
#define XB_XCNT(j)  (256  + 64 * (j))
#define XB_XSUB(j)  (1280 + 64 * (j))
#define XB_XGEN(j)  (2304 + 64 * (j))
#define XB_TOP      3328
#define XB_TOPGEN   3392
#define XCD_BAR_WORDS 3456
#define XB_SPIN_CAP (1u << 18)
__device__ __forceinline__ unsigned xb_ld(unsigned* p)              { return __hip_atomic_load(p, __ATOMIC_RELAXED, __HIP_MEMORY_SCOPE_AGENT); }
__device__ __forceinline__ unsigned xb_add(unsigned* p, unsigned v) { return __hip_atomic_fetch_add(p, v, __ATOMIC_RELAXED, __HIP_MEMORY_SCOPE_AGENT); }
__device__ __forceinline__ unsigned xb_xcc_id() { return (unsigned)__builtin_amdgcn_s_getreg((3 << 11) | 20) & 0xFu; }
#define XB_SPIN(cond, bar) do { unsigned _sp = 0; while (cond) { __builtin_amdgcn_s_sleep(1); \
    if ((++_sp & 255u) == 0u) { if (xb_ld(&(bar)[XB_TMO])) break; if (_sp > XB_SPIN_CAP) { atomicAdd(&(bar)[XB_TMO], 1u); break; } } } } while (0)
struct XcdBarrier { unsigned* bar; unsigned x; volatile LAS unsigned* st; };
__device__ __forceinline__ XcdBarrier xcd_barrier_post(unsigned* bar, volatile LAS unsigned* st) {
    XcdBarrier b; b.bar = bar; b.x = xb_xcc_id(); b.st = st;
    if (threadIdx.x == 0) (void)xb_add(&bar[XB_XCNT(b.x)], 1u);
    return b;
}
__device__ __forceinline__ void xcd_barrier_complete(unsigned* bar, unsigned x, unsigned& nloc, unsigned& nx) {
    const unsigned G = gridDim.x * gridDim.y * gridDim.z;
    unsigned sum, cnt, mine, sp = 0u;
    for (;;) {
        sum = 0u; cnt = 0u; mine = 0u;
#pragma unroll
        for (unsigned j = 0; j < 16; ++j) { const unsigned c = xb_ld(&bar[XB_XCNT(j)]); sum += c; cnt += (c > 0u) ? 1u : 0u; mine = (j == x) ? c : mine; }
        if (sum == G) break;
        __builtin_amdgcn_s_sleep(1);
        if ((++sp & 255u) == 0u) { if (xb_ld(&bar[XB_TMO])) break; if (sp > XB_SPIN_CAP) { atomicAdd(&bar[XB_TMO], 1u); break; } }
    }
    nloc = mine > 0u ? mine : 1u; nx = cnt > 0u ? cnt : 1u;
}
__device__ __forceinline__ void xcd_barrier(const XcdBarrier& b) {
    asm volatile("s_waitcnt vmcnt(0)" ::: "memory");
    __syncthreads();
    if (threadIdx.x == 0) {
        unsigned* bar = b.bar;
        __builtin_amdgcn_s_waitcnt(0);
        unsigned nloc = b.st[0], nx = b.st[1];
        if (nloc == 0u) { xcd_barrier_complete(bar, b.x, nloc, nx); b.st[0] = nloc; b.st[1] = nx; }
        const unsigned old = xb_add(&bar[XB_XSUB(b.x)], 1u);
        const unsigned gen = old / nloc;
        if (old + 1u == (gen + 1u) * nloc) {
            __builtin_amdgcn_fence(__ATOMIC_RELEASE, "agent");
            asm volatile("s_waitcnt vmcnt(0)" ::: "memory");
            const unsigned og = xb_add(&bar[XB_TOP], 1u);
            const unsigned tg = og / nx;
            if (og + 1u == (tg + 1u) * nx) xb_add(&bar[XB_TOPGEN], 1u);
            else XB_SPIN(xb_ld(&bar[XB_TOPGEN]) == tg, bar);
            __builtin_amdgcn_fence(__ATOMIC_ACQUIRE, "agent");
            xb_add(&bar[XB_XGEN(b.x)], 1u);
            asm volatile("s_waitcnt vmcnt(0)" ::: "memory");
        } else {
            XB_SPIN(xb_ld(&bar[XB_XGEN(b.x)]) == gen, bar);
            __builtin_amdgcn_fence(__ATOMIC_ACQUIRE, "agent");
            asm volatile("s_waitcnt vmcnt(0)" ::: "memory");
        }
    }
    __syncthreads();
}

struct Frame {
    LAS unsigned char* lds;
    volatile LAS unsigned* MISC;
    gu32* ctl;
    int tid, lane, wave;
    int vcu, G;
    const float *x, *c, *ctx, *c_ctx, *ada_w, *ada_b, *norm_g, *hg_w_in, *hg_lb, *hg_ng, *hg_w_out, *ft_w_in, *ft_w_out, *final_g;
    unsigned char* ws; unsigned char* o;
};

__device__ __forceinline__ int my_lane() { unsigned z = 0u; asm volatile("" : "+v"(z)); return (int)__builtin_amdgcn_mbcnt_hi(~0u, __builtin_amdgcn_mbcnt_lo(~0u, z)); }
__device__ __forceinline__ float wave_sum(float v) {
#pragma unroll
    for (int o = 1; o < 64; o <<= 1) v += __shfl_xor(v, o);
    return v;
}

__device__ __forceinline__ void p0_transpose_item(const float* W, int K, int N, int k0, int n0, h16* WT, int out_row0, LAS float* scr, int lane) {
#pragma unroll 8
    for (int i = 0; i < 32; ++i) { const int kk = 2 * i + (lane >> 5); scr[kk * 33 + (lane & 31)] = W[(size_t)(k0 + kk) * N + n0 + (lane & 31)]; }
    LDS_WAIT(); asm volatile("" ::: "memory");
    const int c = lane & 7;
#pragma unroll
    for (int j = 0; j < 4; ++j) { const int n = (lane >> 3) + 8 * j; const LAS float* s = scr + (8 * c) * 33 + n;
        v4u o; o.x = pk2h(s[0 * 33], s[1 * 33]); o.y = pk2h(s[2 * 33], s[3 * 33]); o.z = pk2h(s[4 * 33], s[5 * 33]); o.w = pk2h(s[6 * 33], s[7 * 33]);
        *(GAS v4u*)(WT + (size_t)(out_row0 + n) * K + k0 + 8 * c) = o; }
    LDS_WAIT(); asm volatile("" ::: "memory");
}
__device__ __forceinline__ void p0_prologue(Frame& F) {
    {
        LAS float* red = (LAS float*)(F.lds + RING_OFF);
        LAS float* sc = (LAS float*)(F.lds + RING_OFF + 8192);
        bool have = false;
        for (int it = F.vcu; it < 192; it += F.G) {
            if (!have) {
                for (int k = F.tid; k < 3 * D; k += NWAVES * 64) { const int v = k / D, kk = k % D; const float cv = (v == 0) ? F.c[kk] : (v == 1) ? F.c[D + kk] : F.c_ctx[kk]; sc[k] = silu_f(cv); }
                __syncthreads(); have = true;
            }
            const int i = it / 96, n0 = (it % 96) * 32, nl = F.tid & 31, kg = F.tid >> 5;
            const float* W = F.ada_w + (size_t)i * D * 3 * D + n0 + nl;
            float a0 = 0.f, a1 = 0.f, a2 = 0.f;
#pragma unroll 16
            for (int k = kg * 64; k < kg * 64 + 64; ++k) { const float w = W[(size_t)k * (3 * D)]; a0 += sc[k] * w; a1 += sc[D + k] * w; a2 += sc[2 * D + k] * w; }
            red[(kg * 3 + 0) * 32 + nl] = a0; red[(kg * 3 + 1) * 32 + nl] = a1; red[(kg * 3 + 2) * 32 + nl] = a2;
            __syncthreads();
            if (F.tid < 96) { const int v = F.tid >> 5, n = F.tid & 31; float s = 0.f;
#pragma unroll
                for (int q = 0; q < 16; ++q) s += red[(q * 3 + v) * 32 + n];
                s += F.ada_b[i * 3 * D + n0 + n];
                float* mod = (float*)(F.ws + WS_MOD);
                if (i == 0) mod[v * 3 * D + n0 + n] = s; else if (v < 2) mod[(3 + v) * 3 * D + n0 + n] = s; }
            __syncthreads();
        }
        __syncthreads();
    }
    const int gw = F.vcu * NWAVES + F.wave, NGW = F.G * NWAVES;
    const int gt = gw * 64 + F.lane, NGT = NGW * 64;
    {
        float* lbv = (float*)(F.ws + WS_LB);
        for (int i = gt; i < 2 * E; i += NGT) { const float l0 = F.hg_lb[i], l1 = F.hg_lb[2 * E + i]; lbv[i] = 1.f / (1.f + __expf(l1 - l0)); }
        h16* f128 = (h16*)(F.ws + WS_F128);
        for (int i = gt; i < 256 * 128; i += NGT) { const int r = i >> 7, n1 = i & 127, k1 = r & 127; float s, c; sincospif(2.f * (float)((k1 * n1) & 127) / 128.f, &s, &c);
            const float v = (r < 128 ? c : -s) * 0.08838834764831845f; f128[i] = f2h(v); }
        h16* g64 = (h16*)(F.ws + WS_G64);
        for (int i = gt; i < 128 * 128; i += NGT) { const int r = i >> 7, cc = i & 127, k2 = r & 63, n2 = cc & 63; float s, c; sincospif(2.f * (float)((k2 * n2) & 63) / 64.f, &s, &c);
            float v; if (r < 64) v = (cc < 64) ? c : s; else v = (cc < 64) ? -s : c; g64[i] = f2h(v * 0.125f); }
        h16* fct = (h16*)(F.ws + WS_FCT);
        for (int i = gt; i < 256 * 512; i += NGT) { const int m = i >> 9, cc = i & 511, j = cc & 255; float s, c; sincospif(2.f * (float)((j * m) & 255) / 256.f, &s, &c);
            fct[i] = f2h((cc < 256 ? c : s) * 0.0625f); }
        float* twc = (float*)(F.ws + WS_TWC); float* tws = (float*)(F.ws + WS_TWS);
        for (int i = gt; i < 128 * 64; i += NGT) { const int k1 = i >> 6, n2 = i & 63; float s, c; sincospif(2.f * (float)(k1 * n2) / 8192.f, &s, &c); twc[i] = c; tws[i] = s; }
    }
    {
        LAS float* scr = (LAS float*)(F.lds + RING_OFF + F.wave * 16384);
        constexpr int I_IN = (D / 64) * (5 * E / 32), I_OUT = (E / 64) * (D / 32), I_FI = (D / 64) * (2 * E / 32), I_FO = (E / 64) * (D / 32);
        constexpr int NITEMS = I_IN + I_OUT + I_FI + I_FO;
        for (int it = gw; it < NITEMS; it += NGW) {
            int r = it;
            if (r < I_IN) { const int nblk = 5 * E / 32, kb = r / nblk, nb = r % nblk, n0 = nb * 32; const int s = n0 / E, h = (n0 % E) / HD, d0 = n0 % HD;
                const int rho = (h / HPH) * NINH + s * (HPH * HD) + (h % HPH) * HD + d0;
                p0_transpose_item(F.hg_w_in, D, 5 * E, kb * 64, n0, (h16*)(F.ws + WS_WIN), rho, scr, F.lane); continue; } r -= I_IN;
            if (r < I_OUT) { const int nblk = D / 32, kb = r / nblk, nb = r % nblk; p0_transpose_item(F.hg_w_out, E, D, kb * 64, nb * 32, (h16*)(F.ws + WS_WOUT), nb * 32, scr, F.lane); continue; } r -= I_OUT;
            if (r < I_FI) { const int nblk = 2 * E / 32, kb = r / nblk, nb = r % nblk; p0_transpose_item(F.ft_w_in, D, 2 * E, kb * 64, nb * 32, (h16*)(F.o + O_FTIN), nb * 32, scr, F.lane); continue; } r -= I_FI;
            { const int nblk = D / 32, kb = r / nblk, nb = r % nblk; p0_transpose_item(F.ft_w_out, E, D, kb * 64, nb * 32, (h16*)(F.ws + WS_FTOUT), nb * 32, scr, F.lane); }
        }
    }
}

__device__ __forceinline__ void modnorm_row(const f32x4 (&v)[4], const float* g, const float* sh, const float* scl, h16* orow, int lane) {
    float s2 = 0.f;
#pragma unroll
    for (int j = 0; j < 4; ++j) s2 += (v[j].x * v[j].x + v[j].y * v[j].y) + (v[j].z * v[j].z + v[j].w * v[j].w);
    const float rstd = 1.f / sqrtf(wave_sum(s2) * (1.f / D) + EPS);
    GAS v2u* o8 = (GAS v2u*)orow + lane;
#pragma unroll
    for (int j = 0; j < 4; ++j) {
        const f32x4 gg = *((const GAS f32x4*)g + lane + 64 * j), ss = *((const GAS f32x4*)sh + lane + 64 * j), cc = *((const GAS f32x4*)scl + lane + 64 * j);
        const f32x4 h = v[j] * rstd * gg * (cc + 1.f) + ss;
        v2u w; w.x = pk2h(h.x, h.y); w.y = pk2h(h.z, h.w); o8[64 * j] = w;
    }
}
__device__ __forceinline__ void p_norm0(Frame& F) {
    const int gw = F.vcu * NWAVES + F.wave, NGW = F.G * NWAVES;
    const float* mod = (const float*)(F.ws + WS_MOD);
    for (int m = gw; m < M + MC; m += NGW) {
        const float* xrow; h16* orow; int mv;
        if (m < M) { xrow = F.x + (size_t)m * D; orow = (h16*)(F.ws + WS_H0) + (size_t)m * D; mv = m >> 13; }
        else { const int mc = m - M; xrow = F.ctx + (size_t)mc * D; orow = (h16*)(F.ws + WS_H0C) + (size_t)mc * D; mv = 2; }
        f32x4 v[4];
#pragma unroll
        for (int j = 0; j < 4; ++j) v[j] = *((const GAS f32x4*)xrow + F.lane + 64 * j);
        modnorm_row(v, F.norm_g, mod + mv * 3 * D, mod + mv * 3 * D + D, orow, F.lane);
    }
}
__device__ __forceinline__ void p_norm1(Frame& F) {
    const int gw = F.vcu * NWAVES + F.wave, NGW = F.G * NWAVES;
    const float* mod = (const float*)(F.ws + WS_MOD);
    for (int m = gw; m < M; m += NGW) {
        const int b = m >> 13, t = m & (T - 1), rp = (t & 63) * 128 + (t >> 6);
        const float* xrow = F.x + (size_t)m * D; const h16* drow = (const h16*)(F.ws + WS_H0) + (size_t)m * D;
        h16* orow = (h16*)(F.ws + WS_H1P) + (size_t)(b * T + rp) * D;
        f32x4 v[4];
#pragma unroll
        for (int j = 0; j < 4; ++j) { v[j] = *((const GAS f32x4*)xrow + F.lane + 64 * j); const v2u dd = *((const GAS v2u*)drow + F.lane + 64 * j);
            v[j].x += h2f((h16)(dd.x & 0xffff)); v[j].y += h2f((h16)(dd.x >> 16)); v[j].z += h2f((h16)(dd.y & 0xffff)); v[j].w += h2f((h16)(dd.y >> 16)); }
        modnorm_row(v, F.norm_g + D, mod + (3 + b) * 3 * D, mod + (3 + b) * 3 * D + D, orow, F.lane);
    }
}
__device__ __forceinline__ void p_final(Frame& F) {
    const int gw = F.vcu * NWAVES + F.wave, NGW = F.G * NWAVES;
    for (int m = gw; m < M; m += NGW) {
        const float* xrow = F.x + (size_t)m * D; const h16* drow = (const h16*)(F.ws + WS_H0) + (size_t)m * D; float* orow = (float*)F.o + (size_t)m * D;
        f32x4 v[4]; float s2 = 0.f;
#pragma unroll
        for (int j = 0; j < 4; ++j) { v[j] = *((const GAS f32x4*)xrow + F.lane + 64 * j) + *((const GAS f32x4*)orow + F.lane + 64 * j); const v2u dd = *((const GAS v2u*)drow + F.lane + 64 * j);
            v[j].x += h2f((h16)(dd.x & 0xffff)); v[j].y += h2f((h16)(dd.x >> 16)); v[j].z += h2f((h16)(dd.y & 0xffff)); v[j].w += h2f((h16)(dd.y >> 16));
            s2 += (v[j].x * v[j].x + v[j].y * v[j].y) + (v[j].z * v[j].z + v[j].w * v[j].w); }
        const float rstd = 1.f / sqrtf(wave_sum(s2) * (1.f / D) + EPS);
#pragma unroll
        for (int j = 0; j < 4; ++j) { const f32x4 gg = *((const GAS f32x4*)F.final_g + F.lane + 64 * j); *((GAS f32x4*)orow + F.lane + 64 * j) = v[j] * rstd * gg; }
    }
}

__device__ __forceinline__ float fexp(float x) { return __builtin_amdgcn_exp2f(x * 1.4426950408889634f); }
__device__ __forceinline__ float fsilu(float x) { return x * __builtin_amdgcn_rcpf(1.f + fexp(-x)); }
__device__ __forceinline__ float fsigm(float x) { return __builtin_amdgcn_rcpf(1.f + fexp(-x)); }
__device__ __forceinline__ float flog(float x) { return __builtin_amdgcn_logf(x) * 0.6931471805599453f; }
__device__ __forceinline__ v4u pack8h(const f32x4& a, const f32x4& b) { v4u w; w.x = pk2h(a[0], a[1]); w.y = pk2h(a[2], a[3]); w.z = pk2h(b[0], b[1]); w.w = pk2h(b[2], b[3]); return w; }
#define EPI_ST16(base, off, val) (*(GAS v4u*)((base) + (size_t)(unsigned)(off)) = (val))

struct EpiInProj0 {
    static constexpr bool PERM = true, AFTER_DRAIN = false;
    unsigned char* ws; unsigned char* o; const float* lbv; int half;
    __device__ __forceinline__ void operator()(const f32x4 (&acc)[2][2][4][2], const pg8::Unit& u, int wr, int wc, int fr, int fq) const {
        asm volatile("" : "+v"(fr), "+v"(fq));
        const int s = u.pn >> 2; const bool isctx = u.pm < 2;
        if (isctx && (s == 0 || s == 4)) return;
        const unsigned dcol = (unsigned)(wc * 32 + 8 * fq);
#pragma unroll
        for (int bj = 0; bj < 2; ++bj) {
            const unsigned hl = (unsigned)((u.pn & 3) * 2 + bj);
            f32x4 lb0 = (f32x4){0.f, 0.f, 0.f, 0.f}, lb1 = lb0;
            if (s == 1 || s == 2) { const float* lp = lbv + (s - 1) * E + (half * HPH + (int)hl) * HD + (int)dcol; lb0 = *(const GAS f32x4*)lp; lb1 = *(const GAS f32x4*)(lp + 4); }
            unsigned char* base; unsigned off0;
            if (isctx) { base = o + O_CTXS; off0 = ((((unsigned)(half * 3 + (s - 1)) * BATCH + (unsigned)u.pm) * HPH + hl) * (unsigned)(CTX * HD) + dcol) * 2u; }
            else { const unsigned pml = (unsigned)(u.pm - 2), b = pml >> 5, t0 = (pml & 31u) * 256u;
                if (s == 0) { base = ws + WS_Q; off0 = (((b * NH + (unsigned)(half * HPH) + hl) * (unsigned)T + t0) * HD + dcol) * 2u; }
                else { base = ws + (s == 1 ? WS_GF : s == 2 ? WS_GB : s == 3 ? WS_V : WS_Z); off0 = (((b * HPH + hl) * (unsigned)T + t0) * HD + dcol) * 2u; } }
#pragma unroll
            for (int ai = 0; ai < 2; ++ai)
#pragma unroll
                for (int m = 0; m < 4; ++m) {
                    const unsigned rowt = (unsigned)(ai * 128 + wr * 64 + m * 16 + fr);
                    f32x4 v0 = acc[ai][bj][m][0], v1 = acc[ai][bj][m][1];
                    if (s == 0 || s == 4) {
#pragma unroll
                        for (int j = 0; j < 4; ++j) { v0[j] = fsilu(v0[j]); v1[j] = fsilu(v1[j]); }
                    } else if (s != 3) {
#pragma unroll
                        for (int j = 0; j < 4; ++j) { v0[j] = flog(lb0[j] + (1.f - lb0[j]) * fsigm(v0[j])); v1[j] = flog(lb1[j] + (1.f - lb1[j]) * fsigm(v1[j])); }
                    }
                    EPI_ST16(base, off0 + rowt * (unsigned)(HD * 2), pack8h(v0, v1));
                }
        }
    }
};
struct EpiOut0 {
    static constexpr bool PERM = true, AFTER_DRAIN = false;
    unsigned char* ws; const float* mod;
    __device__ __forceinline__ void operator()(const f32x4 (&acc)[2][2][4][2], const pg8::Unit& u, int wr, int wc, int fr, int fq) const {
        asm volatile("" : "+v"(fr), "+v"(fq));
        const int b = u.pm >> 5;
#pragma unroll
        for (int bj = 0; bj < 2; ++bj) {
            const unsigned col = (unsigned)(u.pn * 256 + bj * 128 + wc * 32 + 8 * fq);
            const float* gp = mod + b * 3 * D + 2 * D + (int)col; const f32x4 g0 = *(const GAS f32x4*)gp, g1 = *(const GAS f32x4*)(gp + 4);
#pragma unroll
            for (int ai = 0; ai < 2; ++ai)
#pragma unroll
                for (int m = 0; m < 4; ++m) { const unsigned row = (unsigned)(u.pm * 256 + ai * 128 + wr * 64 + m * 16 + fr);
                    EPI_ST16(ws + WS_H0, (row * (unsigned)D + col) * 2u, pack8h(acc[ai][bj][m][0] * g0, acc[ai][bj][m][1] * g1)); }
        }
    }
};
struct EpiU {
    static constexpr bool PERM = true, AFTER_DRAIN = false;
    unsigned char* ws;
    __device__ __forceinline__ void operator()(const f32x4 (&acc)[2][2][4][2], const pg8::Unit& u, int wr, int wc, int fr, int fq) const {
        asm volatile("" : "+v"(fr), "+v"(fq));
#pragma unroll
        for (int bj = 0; bj < 2; ++bj) {
            const unsigned col = (unsigned)(u.pn * 256 + bj * 128 + wc * 32 + 8 * fq), b = col >> 13, rp = col & (unsigned)(T - 1);
#pragma unroll
            for (int ai = 0; ai < 2; ++ai)
#pragma unroll
                for (int m = 0; m < 4; ++m) { const unsigned ch = (unsigned)(u.pm * 256 + ai * 128 + wr * 64 + m * 16 + fr);
                    EPI_ST16(ws + WS_UT, ((b * (unsigned)E + ch) * (unsigned)T + rp) * 2u, pack8h(acc[ai][bj][m][0], acc[ai][bj][m][1])); }
        }
    }
};
struct EpiZ {
    static constexpr bool PERM = true, AFTER_DRAIN = false;
    unsigned char* ws;
    __device__ __forceinline__ void operator()(const f32x4 (&acc)[2][2][4][2], const pg8::Unit& u, int wr, int wc, int fr, int fq) const {
        asm volatile("" : "+v"(fr), "+v"(fq));
#pragma unroll
        for (int ai = 0; ai < 2; ++ai)
#pragma unroll
            for (int m = 0; m < 4; ++m) {
                const unsigned row = (unsigned)(u.pm * 256 + ai * 128 + wr * 64 + m * 16 + fr), b = row >> 13, rp = row & (unsigned)(T - 1), t = 64u * (rp & 127u) + (rp >> 7);
#pragma unroll
                for (int bj = 0; bj < 2; ++bj) { const unsigned col = (unsigned)(u.pn * 256 + bj * 128 + wc * 32 + 8 * fq);
                    f32x4 v0 = acc[ai][bj][m][0], v1 = acc[ai][bj][m][1];
#pragma unroll
                    for (int j = 0; j < 4; ++j) { v0[j] = fsilu(v0[j]); v1[j] = fsilu(v1[j]); }
                    EPI_ST16(ws + WS_Q, ((b * (unsigned)T + t) * (unsigned)E + col) * 2u, pack8h(v0, v1)); }
            }
    }
};
struct EpiOut1 {
    static constexpr bool PERM = false, AFTER_DRAIN = false;
    unsigned char* o; const float* mod;
    __device__ __forceinline__ void operator()(const f32x4 (&acc)[2][2][4][2], const pg8::Unit& u, int wr, int wc, int fr, int fq) const {
        asm volatile("" : "+v"(fr), "+v"(fq));
        const int b = u.pm >> 5;
#pragma unroll
        for (int bj = 0; bj < 2; ++bj)
#pragma unroll
            for (int n = 0; n < 2; ++n) {
                const unsigned col = (unsigned)(u.pn * 256 + bj * 128 + wc * 32 + n * 16 + 4 * fq);
                const f32x4 gt = *(const GAS f32x4*)(mod + (3 + b) * 3 * D + 2 * D + (int)col);
#pragma unroll
                for (int ai = 0; ai < 2; ++ai)
#pragma unroll
                    for (int m = 0; m < 4; ++m) { const unsigned row = (unsigned)(u.pm * 256 + ai * 128 + wr * 64 + m * 16 + fr);
                        *(GAS f32x4*)(o + (size_t)((row * (unsigned)D + col) * 4u)) = acc[ai][bj][m][n] * gt; }
            }
    }
};

__device__ __forceinline__ void p_scan_simple(Frame& F, int half) {
    LAS float* qs = (LAS float*)(F.lds + RING_OFF);
    LAS float* fs = qs + 1024; LAS float* ks = fs + 1024; LAS float* vs = ks + 1024;
    LAS float* op = vs + 1024;
    LAS float* red = op + 4096;
    const int dv = F.tid & 127, cq = F.tid >> 7;
    for (int it = F.vcu; it < BATCH * HPH; it += F.G) {
        const int b = it / HPH, hl = it % HPH, h = half * HPH + hl;
        h16* qb = (h16*)(F.ws + WS_Q) + (size_t)(b * NH + h) * T * HD;
        h16* vb = (h16*)(F.ws + WS_V) + (size_t)(b * HPH + hl) * T * HD;
        h16* zb = (h16*)(F.ws + WS_Z) + (size_t)(b * HPH + hl) * T * HD;
        h16* gbb = (h16*)(F.ws + WS_GB) + (size_t)(b * HPH + hl) * T * HD;
        const float ng = F.hg_ng[dv];
        for (int dir = 1; dir >= 0; --dir) {
            h16* gl = (h16*)(F.ws + (dir ? WS_GB : WS_GF)) + (size_t)(b * HPH + hl) * T * HD;
            const h16* gc = (const h16*)(F.o + O_CTXS) + ((size_t)((half * 3 + dir) * BATCH + b) * HPH + hl) * (CTX * HD);
            const h16* vc = (const h16*)(F.o + O_CTXS) + ((size_t)((half * 3 + 2) * BATCH + b) * HPH + hl) * (CTX * HD);
            float S[32];
#pragma unroll
            for (int i = 0; i < 32; ++i) S[i] = 0.f;
            const int nblk = (CTX + T) / 8;
            for (int bi = 0; bi < nblk; ++bi) {
                const bool isctx = bi < CTX / 8;
                const int bl = isctx ? bi : bi - CTX / 8, nb = isctx ? CTX / 8 : T / 8;
                const int t0 = (dir ? (nb - 1 - bl) : bl) * 8;
#pragma unroll
                for (int e = 0; e < 2; ++e) { const int idx = F.tid + e * 512, off = t0 * HD + idx;
                    const float g = h2f(isctx ? gc[off] : gl[off]); const float f = __expf(g);
                    fs[idx] = f; ks[idx] = 1.f - f; vs[idx] = h2f(isctx ? vc[off] : vb[off]); qs[idx] = isctx ? 0.f : h2f(qb[off]); }
                __syncthreads();
#pragma unroll 1
                for (int j = 0; j < 8; ++j) { const int jj = dir ? 7 - j : j; const float vv = vs[jj * 128 + dv]; float po = 0.f;
#pragma unroll
                    for (int i = 0; i < 32; ++i) { const int c = cq * 32 + i; S[i] = fs[jj * 128 + c] * S[i] + ks[jj * 128 + c] * vv; po += S[i] * qs[jj * 128 + c]; }
                    op[(jj * 4 + cq) * 128 + dv] = po; }
                __syncthreads();
                if (!isctx) {
                    float ov[2];
#pragma unroll
                    for (int e = 0; e < 2; ++e) { const int jj = (F.tid >> 7) + 4 * e; ov[e] = (op[(jj * 4 + 0) * 128 + dv] + op[(jj * 4 + 1) * 128 + dv]) + (op[(jj * 4 + 2) * 128 + dv] + op[(jj * 4 + 3) * 128 + dv]); }
                    if (dir == 1) {
#pragma unroll
                        for (int e = 0; e < 2; ++e) { const int jj = (F.tid >> 7) + 4 * e; gbb[(size_t)(t0 + jj) * HD + dv] = f2h(ov[e]); }
                    } else {
#pragma unroll
                        for (int e = 0; e < 2; ++e) { const int jj = (F.tid >> 7) + 4 * e; ov[e] += h2f(gbb[(size_t)(t0 + jj) * HD + dv]);
                            const float ss = wave_sum(ov[e] * ov[e]); if (F.lane == 0) red[jj * 2 + (F.wave & 1)] = ss; }
                        __syncthreads();
#pragma unroll
                        for (int e = 0; e < 2; ++e) { const int jj = (F.tid >> 7) + 4 * e; const float rstd = 1.f / sqrtf((red[jj * 2] + red[jj * 2 + 1]) * (1.f / HD) + EPS);
                            const float y = ov[e] * rstd * ng * h2f(zb[(size_t)(t0 + jj) * HD + dv]); qb[(size_t)(t0 + jj) * HD + dv] = f2h(y); }
                    }
                }
                __syncthreads();
            }
        }
    }
}

typedef short v4s __attribute__((ext_vector_type(4)));
typedef __bf16 bf2_t __attribute__((ext_vector_type(2)));
using pg8::bf16x8; using pg8::f16x8;
constexpr int NSEG = 16, SEGC = 8, CH = 64;
__device__ __forceinline__ unsigned pk2bf(float lo, float hi) { f32x2 v = {lo, hi}; bf2_t b = __builtin_convertvector(v, bf2_t); return __builtin_bit_cast(unsigned, b); }
__device__ __forceinline__ int img_off(int row, int ch) { return 256 * row + 16 * (ch ^ (((row & 3) << 2) | ((row >> 2) & 3))); }
__device__ __forceinline__ bf16x8 row_frag(const LAS unsigned char* img, int rb, int s, int lane) {
    return *(const LAS bf16x8*)(img + img_off((lane & 15) + 16 * rb, 4 * s + (lane >> 4)));
}
__device__ __forceinline__ bf16x8 tr_frag(const LAS unsigned char* img, int c, int ks, int lane) {
    const int g = lane >> 4, q = (lane & 15) >> 2, p = lane & 3;
    const int a0 = img_off(32 * ks + 8 * g + q, 2 * c + (p >> 1)) + 8 * (p & 1);
    const int a1 = img_off(32 * ks + 8 * g + 4 + q, 2 * c + (p >> 1)) + 8 * (p & 1);
    const v4s lo = __builtin_bit_cast(v4s, __builtin_amdgcn_ds_read_tr16_b64_v4i16((LAS v4s*)(img + a0)));
    const v4s hi = __builtin_bit_cast(v4s, __builtin_amdgcn_ds_read_tr16_b64_v4i16((LAS v4s*)(img + a1)));
    return (bf16x8){lo[0], lo[1], lo[2], lo[3], hi[0], hi[1], hi[2], hi[3]};
}
__device__ __forceinline__ float h_lo(unsigned u) { return h2f((h16)(u & 0xffff)); }
__device__ __forceinline__ float h_hi(unsigned u) { return h2f((h16)(u >> 16)); }
__device__ __forceinline__ float* pst_ptr(Frame& F, int dir, int b, int hl, int seg) { return (float*)(F.o + O_PST) + ((size_t)(((dir * BATCH + b) * HPH + hl) * NSEG + seg) << 14); }
__device__ __forceinline__ float* sctx_ptr(Frame& F, int dir, int b, int hl) { return (float*)(F.o + O_SCTX) + ((size_t)((dir * BATCH + b) * HPH + hl) << 14); }
__device__ __forceinline__ float* dvec_ptr(Frame& F, int dir, int b, int hl, int seg) { return (float*)(F.ws + WS_DVEC) + (size_t)((((dir * BATCH + b) * HPH + hl) * NSEG + seg) << 7); }
__device__ __forceinline__ void st_store(float* P, const f32x4 (&St)[8], int w, int fr, int fq) {
#pragma unroll
    for (int ct = 0; ct < 8; ++ct)
#pragma unroll
        for (int r = 0; r < 4; ++r) P[(16 * w + 4 * fq + r) * 128 + 16 * ct + fr] = St[ct][r];
}
__device__ __forceinline__ void st_load(const float* P, f32x4 (&St)[8], int w, int fr, int fq) {
#pragma unroll
    for (int ct = 0; ct < 8; ++ct)
#pragma unroll
        for (int r = 0; r < 4; ++r) St[ct][r] = P[(16 * w + 4 * fq + r) * 128 + 16 * ct + fr];
}

__device__ __forceinline__ void p1_run(Frame& F, const unsigned char* base, unsigned gf, unsigned gb, unsigned vv, int nch, f32x4 (&Pf)[8], f32x4 (&Pb)[8], float (&totf)[2], float (&rhead)[2]) {
    LAS unsigned char* lds = F.lds;
    constexpr int KF = 0, KB = 16384, VI = 32768, TOTF = 49152, TOTB = 53248, DCH = 57344;
    const int tid = F.tid, w = F.wave, cp = tid & 63, tg = tid >> 6;
    LAS float* totF = (LAS float*)(lds + TOTF); LAS float* totB = (LAS float*)(lds + TOTB); LAS float* dch = (LAS float*)(lds + DCH);
    unsigned ugf[8], ugb[8], uv[8];
#define P1_LD(off) (*(const GAS unsigned*)(base + (size_t)(unsigned)(off)))
    { const unsigned tb = (unsigned)((tg * 8) * HD + 2 * cp) * 2u;
#pragma unroll
      for (int i = 0; i < 8; ++i) { ugf[i] = P1_LD(gf + tb + i * HD * 2); ugb[i] = P1_LD(gb + tb + i * HD * 2); uv[i] = P1_LD(vv + tb + i * HD * 2); } }
#pragma unroll 1
    for (int ci = 0; ci < nch; ++ci) {
        int lane = F.lane; asm volatile("" : "+v"(lane));
        const int fr = lane & 15;
        float gf0[8], gf1[8], gb0[8], gb1[8]; float sf0 = 0.f, sf1 = 0.f, sb0 = 0.f, sb1 = 0.f;
#pragma unroll
        for (int i = 0; i < 8; ++i) { gf0[i] = h_lo(ugf[i]); gf1[i] = h_hi(ugf[i]); gb0[i] = h_lo(ugb[i]); gb1[i] = h_hi(ugb[i]); sf0 += gf0[i]; sf1 += gf1[i]; sb0 += gb0[i]; sb1 += gb1[i]; }
        *(LAS f32x2*)(totF + tg * 128 + 2 * cp) = (f32x2){sf0, sf1}; *(LAS f32x2*)(totB + tg * 128 + 2 * cp) = (f32x2){sb0, sb1};
        __syncthreads();
        float suf0 = 0.f, suf1 = 0.f, pre0 = rhead[0], pre1 = rhead[1], all_f0 = 0.f, all_f1 = 0.f, all_b0 = 0.f, all_b1 = 0.f;
#pragma unroll
        for (int g2 = 0; g2 < 8; ++g2) { const f32x2 tf = *(const LAS f32x2*)(totF + g2 * 128 + 2 * cp), tbv = *(const LAS f32x2*)(totB + g2 * 128 + 2 * cp);
            all_f0 += tf.x; all_f1 += tf.y; all_b0 += tbv.x; all_b1 += tbv.y;
            if (g2 > tg) { suf0 += tf.x; suf1 += tf.y; } if (g2 < tg) { pre0 += tbv.x; pre1 += tbv.y; } }
        float rs0 = suf0, rs1 = suf1;
        unsigned kfw[8], kbw[8];
#pragma unroll
        for (int i = 7; i >= 0; --i) { const float k0 = (1.f - __expf(gf0[i])) * __expf(rs0), k1 = (1.f - __expf(gf1[i])) * __expf(rs1); kfw[i] = pk2h(k0, k1); rs0 += gf0[i]; rs1 += gf1[i]; }
#pragma unroll
        for (int i = 0; i < 8; ++i) { const float k0 = (1.f - __expf(gb0[i])) * __expf(pre0), k1 = (1.f - __expf(gb1[i])) * __expf(pre1); kbw[i] = pk2h(k0, k1); pre0 += gb0[i]; pre1 += gb1[i]; }
#pragma unroll
        for (int i = 0; i < 8; ++i) { const int o = img_off(tg * 8 + i, cp >> 2) + (cp & 3) * 4;
            *(LAS unsigned*)(lds + KF + o) = kfw[i]; *(LAS unsigned*)(lds + KB + o) = kbw[i]; *(LAS unsigned*)(lds + VI + o) = uv[i]; }
        if (tg == 0) *(LAS f32x2*)(dch + 2 * cp) = (f32x2){__expf(all_f0), __expf(all_f1)};
        totf[0] += all_f0; totf[1] += all_f1; rhead[0] += all_b0; rhead[1] += all_b1;
        if (ci + 1 < nch) { const unsigned tb = (unsigned)(((ci + 1) * CH + tg * 8) * HD + 2 * cp) * 2u;
#pragma unroll
            for (int i = 0; i < 8; ++i) { ugf[i] = P1_LD(gf + tb + i * HD * 2); ugb[i] = P1_LD(gb + tb + i * HD * 2); uv[i] = P1_LD(vv + tb + i * HD * 2); } }
        __syncthreads();
        bf16x8 va[2];
#pragma unroll
        for (int ks = 0; ks < 2; ++ks) va[ks] = tr_frag(lds + VI, w, ks, lane);
#pragma unroll
        for (int ct = 0; ct < 8; ++ct) { const float d = dch[16 * ct + fr]; Pf[ct] = Pf[ct] * d;
#pragma unroll
            for (int ks = 0; ks < 2; ++ks) {
                const bf16x8 kf_ = tr_frag(lds + KF, ct, ks, lane), kb_ = tr_frag(lds + KB, ct, ks, lane);
                Pf[ct] = __builtin_amdgcn_mfma_f32_16x16x32_f16(__builtin_bit_cast(f16x8, va[ks]), __builtin_bit_cast(f16x8, kf_), Pf[ct], 0, 0, 0);
                Pb[ct] = __builtin_amdgcn_mfma_f32_16x16x32_f16(__builtin_bit_cast(f16x8, va[ks]), __builtin_bit_cast(f16x8, kb_), Pb[ct], 0, 0, 0); } }
    }
    __syncthreads();
#undef P1_LD
}
__device__ __forceinline__ void p_scan1(Frame& F, int half) {
    const int w = F.wave, fr = F.lane & 15, fq = F.lane >> 4, cp = F.tid & 63, tg = F.tid >> 6;
    for (int it = F.vcu; it < BATCH * HPH * NSEG; it += F.G) {
        const int b = it / (HPH * NSEG), hl = (it / NSEG) % HPH, seg = it % NSEG;
        f32x4 Pf[8], Pb[8]; float totf[2], rhead[2];
        if (seg == 0) {
#pragma unroll
            for (int ct = 0; ct < 8; ++ct) { Pf[ct] = (f32x4){0.f, 0.f, 0.f, 0.f}; Pb[ct] = (f32x4){0.f, 0.f, 0.f, 0.f}; }
            totf[0] = totf[1] = rhead[0] = rhead[1] = 0.f;
            const unsigned cs = (unsigned)(CTX * HD * 2), o0 = (unsigned)O_CTXS + (unsigned)(((half * 3 + 0) * BATCH + b) * HPH + hl) * cs, o1 = (unsigned)O_CTXS + (unsigned)(((half * 3 + 1) * BATCH + b) * HPH + hl) * cs, o2 = (unsigned)O_CTXS + (unsigned)(((half * 3 + 2) * BATCH + b) * HPH + hl) * cs;
            p1_run(F, F.o, o0, o1, o2, CTX / CH, Pf, Pb, totf, rhead);
            st_store(sctx_ptr(F, 0, b, hl), Pf, w, fr, fq); st_store(sctx_ptr(F, 1, b, hl), Pb, w, fr, fq);
        }
#pragma unroll
        for (int ct = 0; ct < 8; ++ct) { Pf[ct] = (f32x4){0.f, 0.f, 0.f, 0.f}; Pb[ct] = (f32x4){0.f, 0.f, 0.f, 0.f}; }
        totf[0] = totf[1] = rhead[0] = rhead[1] = 0.f;
        const unsigned so = (unsigned)(((b * HPH + hl) * T + seg * SEGC * CH) * HD) * 2u;
        p1_run(F, F.ws, (unsigned)WS_GF + so, (unsigned)WS_GB + so, (unsigned)WS_V + so, SEGC, Pf, Pb, totf, rhead);
        st_store(pst_ptr(F, 0, b, hl, seg), Pf, w, fr, fq); st_store(pst_ptr(F, 1, b, hl, seg), Pb, w, fr, fq);
        if (tg == 0) { *(GAS f32x2*)(dvec_ptr(F, 0, b, hl, seg) + 2 * cp) = (f32x2){__expf(totf[0]), __expf(totf[1])}; *(GAS f32x2*)(dvec_ptr(F, 1, b, hl, seg) + 2 * cp) = (f32x2){__expf(rhead[0]), __expf(rhead[1])}; }
    }
}
__device__ __forceinline__ void p_scan_combine(Frame& F) {
    for (int it = F.vcu; it < 2 * BATCH * HPH * 8; it += F.G) {
        const int sl = it & 7, hl = (it >> 3) % HPH, b = (it >> 3) / HPH % BATCH, dir = (it >> 3) / (HPH * BATCH);
        const int e = sl * 2048 + F.tid * 4, c = e & 127;
        f32x4 tmp[NSEG];
        float* const p0 = pst_ptr(F, dir, b, hl, 0) + e; const float* const d0 = dvec_ptr(F, dir, b, hl, 0) + c;
#pragma unroll
        for (int j = 0; j < NSEG; ++j) tmp[j] = *(const GAS f32x4*)(p0 + ((size_t)j << 14));
        f32x4 Tt = *(const GAS f32x4*)(sctx_ptr(F, dir, b, hl) + e);
#pragma unroll 1
        for (int jj = 0; jj < NSEG; ++jj) { const int j = dir ? NSEG - 1 - jj : jj; const f32x4 dd = *(const GAS f32x4*)(d0 + (j << 7));
            f32x4 tj = tmp[0];
#pragma unroll
            for (int q = 1; q < NSEG; ++q) tj = (q == j) ? tmp[q] : tj;
            *(GAS f32x4*)(p0 + ((size_t)j << 14)) = Tt; Tt = Tt * dd + tj; }
    }
}
template <int DIR> __device__ __forceinline__ void p2_sweep(Frame& F, unsigned qb, unsigned gb_, unsigned vb, unsigned zb, unsigned pb, f32x4 (&St)[8], bool dummy = false) {
    unsigned char* const wsb = F.ws;
#define P2_U32(off) (*(const GAS unsigned*)(wsb + (size_t)(unsigned)(off)))
#define P2_V4(off) (*(GAS v4u*)(wsb + (size_t)(unsigned)(off)))
    LAS unsigned char* lds = F.lds;
    constexpr int QI = 0, KI = 16384, VI = 32768, AI = 49152, SI = 65536, OB = 98304, TOT = 132096, EB = 136192, E2 = 136704;
    const int tid = F.tid, w = F.wave, cp = tid & 63, tg = tid >> 6;
    LAS float* tot = (LAS float*)(lds + TOT); LAS float* eb = (LAS float*)(lds + EB); LAS float* e2 = (LAS float*)(lds + E2); LAS float* ob = (LAS float*)(lds + OB);
    const int ft = tid >> 3, fj = tid & 7;
    unsigned uq[8], ug[8], uv[8];
    { const unsigned tb = (unsigned)(((DIR ? SEGC - 1 : 0) * CH + tg * 8) * HD + 2 * cp) * 2u;
#pragma unroll
      for (int i = 0; i < 8; ++i) { uq[i] = P2_U32(qb + tb + i * HD * 2); ug[i] = P2_U32(gb_ + tb + i * HD * 2); uv[i] = P2_U32(vb + tb + i * HD * 2); } }
#pragma unroll 1
    for (int step = 0; step < SEGC; ++step) {
        int lane = F.lane; asm volatile("" : "+v"(lane));
        const int fr = lane & 15, fq = lane >> 4;
        const int ci = DIR ? SEGC - 1 - step : step;
        const unsigned co = (unsigned)(ci * CH * HD) * 2u;
        float g0[8], g1[8]; float s0 = 0.f, s1 = 0.f;
#pragma unroll
        for (int i = 0; i < 8; ++i) { g0[i] = h_lo(ug[i]); g1[i] = h_hi(ug[i]); s0 += g0[i]; s1 += g1[i]; }
        *(LAS f32x2*)(tot + tg * 128 + 2 * cp) = (f32x2){s0, s1};
        v4u p0, p1, z0, z1;
        if (DIR == 1) { const unsigned fo = co + (unsigned)(ft * HD + 16 * fj) * 2u;
            p0 = P2_V4(pb + fo); p1 = P2_V4(pb + fo + 16); z0 = P2_V4(zb + fo); z1 = P2_V4(zb + fo + 16); }
        __syncthreads();
        float pre0 = 0.f, pre1 = 0.f, be0 = 0.f, be1 = 0.f, al0 = 0.f, al1 = 0.f;
#pragma unroll
        for (int g2 = 0; g2 < 8; ++g2) { const f32x2 tv = *(const LAS f32x2*)(tot + g2 * 128 + 2 * cp); al0 += tv.x; al1 += tv.y;
            if (DIR == 0) { if (g2 < tg) { pre0 += tv.x; pre1 += tv.y; } if (g2 < 4) { be0 += tv.x; be1 += tv.y; } }
            else { if (g2 > tg) { pre0 += tv.x; pre1 += tv.y; } if (g2 >= 4) { be0 += tv.x; be1 += tv.y; } } }
        {
            float r0 = pre0, r1 = pre1;
#pragma unroll
            for (int ii = 0; ii < 8; ++ii) { const int i = DIR ? 7 - ii : ii;
                r0 += g0[i]; r1 += g1[i];
                const float e0 = __expf(r0 - be0), e1 = __expf(r1 - be1), i0 = __expf(be0 - r0), i1 = __expf(be1 - r1);
                const float k0 = 1.f - __expf(g0[i]), k1 = 1.f - __expf(g1[i]);
                const int o = img_off(tg * 8 + i, cp >> 2) + (cp & 3) * 4;
                *(LAS unsigned*)(lds + QI + o) = pk2bf(h_lo(uq[i]) * e0, h_hi(uq[i]) * e1);
                *(LAS unsigned*)(lds + KI + o) = pk2bf(k0 * i0, k1 * i1);
                *(LAS unsigned*)(lds + VI + o) = pk2bf(h_lo(uv[i]), h_hi(uv[i])); }
        }
        if (tg == 0) { *(LAS f32x2*)(eb + 2 * cp) = (f32x2){__expf(be0), __expf(be1)}; *(LAS f32x2*)(e2 + 2 * cp) = (f32x2){__expf(al0 - be0), __expf(al1 - be1)}; }
        if (step + 1 < SEGC) { const unsigned tb = (unsigned)(((DIR ? ci - 1 : ci + 1) * CH + tg * 8) * HD + 2 * cp) * 2u;
#pragma unroll
            for (int i = 0; i < 8; ++i) { uq[i] = P2_U32(qb + tb + i * HD * 2); ug[i] = P2_U32(gb_ + tb + i * HD * 2); uv[i] = P2_U32(vb + tb + i * HD * 2); } }
        __syncthreads();
#pragma unroll
        for (int ct = 0; ct < 8; ++ct) { St[ct] = St[ct] * eb[16 * ct + fr];
            v2u wv; wv.x = pk2bf(St[ct][0], St[ct][1]); wv.y = pk2bf(St[ct][2], St[ct][3]);
            *(LAS v2u*)(lds + SI + img_off(16 * ct + fr, 2 * w + (fq >> 1)) + (fq & 1) * 8) = wv; }
        {
            const int ti = w >> 1;
            f32x4 sc[2] = {(f32x4){0.f, 0.f, 0.f, 0.f}, (f32x4){0.f, 0.f, 0.f, 0.f}};
#pragma unroll
            for (int ks = 0; ks < 4; ++ks) { const bf16x8 qf = row_frag(lds + QI, ti, ks, lane);
#pragma unroll
                for (int u = 0; u < 2; ++u) { const bf16x8 kf = row_frag(lds + KI, 2 * (w & 1) + u, ks, lane); sc[u] = __builtin_amdgcn_mfma_f32_16x16x32_bf16(kf, qf, sc[u], 0, 0, 0); } }
#pragma unroll
            for (int u = 0; u < 2; ++u) { const int sj = 2 * (w & 1) + u, t = 16 * ti + fr; float m[4];
#pragma unroll
                for (int r = 0; r < 4; ++r) { const int sidx = 16 * sj + 4 * fq + r; const bool keep = DIR ? (sidx >= t) : (sidx <= t); m[r] = keep ? sc[u][r] : 0.f; }
                v2u wv; wv.x = pk2bf(m[0], m[1]); wv.y = pk2bf(m[2], m[3]);
                *(LAS v2u*)(lds + AI + img_off(t, 2 * sj + (fq >> 1)) + (fq & 1) * 8) = wv; }
        }
        __syncthreads();
        f32x4 oacc[4];
#pragma unroll
        for (int ti = 0; ti < 4; ++ti) oacc[ti] = (f32x4){0.f, 0.f, 0.f, 0.f};
        bf16x8 va[2];
#pragma unroll
        for (int ks = 0; ks < 2; ++ks) { va[ks] = tr_frag(lds + VI, w, ks, lane);
#pragma unroll
            for (int ti = 0; ti < 4; ++ti) { const bf16x8 af = row_frag(lds + AI, ti, ks, lane); oacc[ti] = __builtin_amdgcn_mfma_f32_16x16x32_bf16(va[ks], af, oacc[ti], 0, 0, 0); } }
#pragma unroll
        for (int ks = 0; ks < 4; ++ks) { const bf16x8 sf = tr_frag(lds + SI, w, ks, lane);
#pragma unroll
            for (int ti = 0; ti < 4; ++ti) { const bf16x8 qf = row_frag(lds + QI, ti, ks, lane); oacc[ti] = __builtin_amdgcn_mfma_f32_16x16x32_bf16(sf, qf, oacc[ti], 0, 0, 0); } }
#pragma unroll
        for (int ct = 0; ct < 8; ++ct) {
#pragma unroll
            for (int ks = 0; ks < 2; ++ks) { const bf16x8 kf = tr_frag(lds + KI, ct, ks, lane); St[ct] = __builtin_amdgcn_mfma_f32_16x16x32_bf16(va[ks], kf, St[ct], 0, 0, 0); }
            St[ct] = St[ct] * e2[16 * ct + fr]; }
#pragma unroll
        for (int ti = 0; ti < 4; ++ti) *(LAS f32x4*)(ob + (16 * ti + fr) * 132 + 16 * w + 4 * fq) = oacc[ti];
        __syncthreads();
        {
            f32x4 ov[4];
#pragma unroll
            for (int i = 0; i < 4; ++i) ov[i] = *(const LAS f32x4*)(ob + ft * 132 + 16 * fj + 4 * i);
            const unsigned fo = co + (unsigned)(ft * HD + 16 * fj) * 2u;
            const unsigned dmy = (unsigned)(WS_XCH) + (unsigned)(blockIdx.x & 7) * (unsigned)(SEGC * CH * HD * 2);
            if (DIR == 0) {
                v4u w0, w1; w0.x = pk2h(ov[0][0], ov[0][1]); w0.y = pk2h(ov[0][2], ov[0][3]); w0.z = pk2h(ov[1][0], ov[1][1]); w0.w = pk2h(ov[1][2], ov[1][3]);
                w1.x = pk2h(ov[2][0], ov[2][1]); w1.y = pk2h(ov[2][2], ov[2][3]); w1.z = pk2h(ov[3][0], ov[3][1]); w1.w = pk2h(ov[3][2], ov[3][3]);
                const unsigned dst = (dummy ? dmy : pb) + fo; P2_V4(dst) = w0; P2_V4(dst + 16) = w1;
            } else {
                const unsigned pu[8] = {p0.x, p0.y, p0.z, p0.w, p1.x, p1.y, p1.z, p1.w}, zu[8] = {z0.x, z0.y, z0.z, z0.w, z1.x, z1.y, z1.z, z1.w};
                float o16[16]; float ss = 0.f;
#pragma unroll
                for (int i = 0; i < 8; ++i) { o16[2 * i] = ov[i >> 1][(2 * i) & 3] + h_lo(pu[i]); o16[2 * i + 1] = ov[i >> 1][(2 * i + 1) & 3] + h_hi(pu[i]); ss += o16[2 * i] * o16[2 * i] + o16[2 * i + 1] * o16[2 * i + 1]; }
                ss += __shfl_xor(ss, 1); ss += __shfl_xor(ss, 2); ss += __shfl_xor(ss, 4);
                const float rstd = 1.f / sqrtf(ss * (1.f / HD) + EPS);
                unsigned yo[8];
#pragma unroll
                for (int i = 0; i < 8; ++i) { const f32x2 ng = *(const GAS f32x2*)(F.hg_ng + 16 * fj + 2 * i);
                    yo[i] = pk2h(o16[2 * i] * rstd * ng.x * h_lo(zu[i]), o16[2 * i + 1] * rstd * ng.y * h_hi(zu[i])); }
                const unsigned dst = (dummy ? dmy : qb) + fo; P2_V4(dst) = (v4u){yo[0], yo[1], yo[2], yo[3]}; P2_V4(dst + 16) = (v4u){yo[4], yo[5], yo[6], yo[7]};
            }
        }
    }
    __syncthreads();
#undef P2_U32
#undef P2_V4
}
__device__ __forceinline__ void p_scan2(Frame& F, int half, bool dummy = false) {
    const int w = F.wave, fr = F.lane & 15, fq = F.lane >> 4;
    for (int it = F.vcu; it < BATCH * HPH * NSEG; it += F.G) {
        const int b = it / (HPH * NSEG), hl = (it / NSEG) % HPH, seg = it % NSEG, h = half * HPH + hl;
        const unsigned qb = (unsigned)WS_Q + (unsigned)(((b * NH + h) * T + seg * SEGC * CH) * HD) * 2u;
        const unsigned so = (unsigned)(((b * HPH + hl) * T + seg * SEGC * CH) * HD) * 2u;
        const unsigned gfb = (unsigned)WS_GF + so, gbb = (unsigned)WS_GB + so, vb = (unsigned)WS_V + so, zb = (unsigned)WS_Z + so;
        f32x4 St[8];
        st_load(pst_ptr(F, 0, b, hl, seg), St, w, fr, fq);
        p2_sweep<0>(F, qb, gfb, vb, zb, gfb, St, dummy);
        st_load(pst_ptr(F, 1, b, hl, seg), St, w, fr, fq);
        p2_sweep<1>(F, qb, gbb, vb, zb, gfb, St, dummy);
    }
}

__device__ __forceinline__ h16* bp_ptr(Frame& F, int b) { return (h16*)(b == 0 ? F.o + O_BP0 : F.ws + WS_BP1); }
__device__ __forceinline__ void p_fftA_simple(Frame& F) {
    LAS float* us = (LAS float*)(F.lds + RING_OFF);
    LAS float* tc = us + 8192; LAS float* ts = tc + 128;
    if (F.tid < 128) { float s, c; sincospif(2.f * (float)F.tid / 128.f, &s, &c); tc[F.tid] = c; ts[F.tid] = s; }
    const float* twc = (const float*)(F.ws + WS_TWC); const float* tws = (const float*)(F.ws + WS_TWS);
    for (int it = F.vcu; it < BATCH * E; it += F.G) {
        const int b = it / E, ch = it % E;
        const h16* u = (const h16*)(F.ws + WS_UT) + (size_t)(b * E + ch) * T;
        __syncthreads();
        for (int i = F.tid; i < T; i += NWAVES * 64) us[i] = h2f(u[i]);
        __syncthreads();
        const int k1 = F.tid & 127, ng = F.tid >> 7;
        h16* bp = bp_ptr(F, b) + ((size_t)k1 * E + ch) * 128;
        for (int q = 0; q < 16; ++q) { const int n2 = ng * 16 + q; float ar = 0.f, ai = 0.f;
            for (int n1 = 0; n1 < 128; ++n1) { const float uv = us[n2 * 128 + n1]; const int ix = (n1 * k1) & 127; ar += uv * tc[ix]; ai -= uv * ts[ix]; }
            ar *= 0.08838834764831845f; ai *= 0.08838834764831845f;
            const float c = twc[k1 * 64 + n2], s = tws[k1 * 64 + n2];
            bp[n2] = f2h(ar * c + ai * s); bp[64 + n2] = f2h(ai * c - ar * s); }
    }
}
__device__ __forceinline__ void p_fftBC_simple(Frame& F) {
    LAS h16* bt = (LAS h16*)(F.lds + RING_OFF);
    LAS h16* vt = (LAS h16*)(F.lds + RING_OFF + 65536);
    LAS float* t64 = (LAS float*)(F.lds + STAB_OFF);
    LAS float* t256 = t64 + 128;
    if (F.tid < 64) { float s, c; sincospif(2.f * (float)F.tid / 64.f, &s, &c); t64[F.tid] = c; t64[64 + F.tid] = s; }
    if (F.tid < 256) { float s, c; sincospif(2.f * (float)F.tid / 256.f, &s, &c); t256[F.tid] = c; t256[256 + F.tid] = s; }
    for (int it = F.vcu; it < BATCH * 128 * 8; it += F.G) {
        const int b = it / 1024, k1 = (it % 1024) / 8, g = it % 8;
        const h16* bp = bp_ptr(F, b) + ((size_t)k1 * E + g * 256) * 128;
        __syncthreads();
        for (int i = F.tid; i < 256 * 128; i += NWAVES * 64) { const int cch = i >> 7, n = i & 127; bt[cch * 128 + ((n + 2 * cch) & 127)] = bp[i]; }
        __syncthreads();
        const int ch = F.tid & 255, kh = F.tid >> 8;
        for (int q = 0; q < 32; ++q) { const int k2 = kh * 32 + q; float ar = 0.f, ai = 0.f;
            for (int n2 = 0; n2 < 64; ++n2) { const float br = h2f(bt[ch * 128 + ((n2 + 2 * ch) & 127)]), bi = h2f(bt[ch * 128 + ((64 + n2 + 2 * ch) & 127)]); const int ix = (n2 * k2) & 63; const float c = t64[ix], s = t64[64 + ix];
                ar += br * c + bi * s; ai += bi * c - br * s; }
            vt[(k2 * 256 + ch) * 2] = f2h(ar * 0.125f); vt[(k2 * 256 + ch) * 2 + 1] = f2h(ai * 0.125f); }
        __syncthreads();
        const int m = ch;
        for (int q = 0; q < 32; ++q) { const int k2 = kh * 32 + q; float a = 0.f;
            for (int j = 0; j < 256; ++j) { const int ix = (j * m) & 255; a += h2f(vt[(k2 * 256 + j) * 2]) * t256[ix] + h2f(vt[(k2 * 256 + j) * 2 + 1]) * t256[256 + ix]; }
            const size_t idx = (size_t)(b * T + k1 + 128 * k2) * E + g * 256 + m;
            const float zz = h2f(((const h16*)(F.ws + WS_Q))[idx]);
            ((h16*)(F.ws + WS_Y1))[idx] = f2h(a * 0.0625f * zz); }
    }
}

struct EpiFftA {
    static constexpr bool PERM = true, AFTER_DRAIN = false;
    unsigned char* ws; unsigned char* o;
    __device__ __forceinline__ void operator()(const pg8::f32x4 (&acc)[2][2][4][2], const pg8::Unit& u, int wr, int wc, int fr, int fq) const {
        asm volatile("" : "+v"(fr), "+v"(fq));
        const unsigned char* twc = ws + WS_TWC; const unsigned char* tws = ws + WS_TWS;
        const int b = u.pn >> 9, ch0 = (u.pn & 511) * 4;
        unsigned char* bp = (b == 0 ? o + O_BP0 : ws + WS_BP1);
        const unsigned n2 = (unsigned)((wc & 1) * 32 + 8 * fq);
#pragma unroll
        for (int m = 0; m < 4; ++m) {
            const unsigned k1 = (unsigned)(wr * 64 + m * 16 + fr), toff = (k1 * 64u + n2) * 4u;
            const f32x4 c0 = *(const GAS f32x4*)(twc + (size_t)toff), c1 = *(const GAS f32x4*)(twc + (size_t)toff + 16), s0 = *(const GAS f32x4*)(tws + (size_t)toff), s1 = *(const GAS f32x4*)(tws + (size_t)toff + 16);
#pragma unroll
            for (int bj = 0; bj < 2; ++bj) {
                const unsigned ch = (unsigned)(ch0 + 2 * bj + (wc >> 1)), doff = ((k1 * (unsigned)E + ch) * 128u + n2) * 2u;
                const f32x4 re0 = acc[0][bj][m][0], re1 = acc[0][bj][m][1], im0 = acc[1][bj][m][0], im1 = acc[1][bj][m][1];
                EPI_ST16(bp, doff, pack8h(re0 * c0 + im0 * s0, re1 * c1 + im1 * s1));
                EPI_ST16(bp, doff + 128u, pack8h(im0 * c0 - re0 * s0, im1 * c1 - re1 * s1));
            }
            asm volatile("" ::: "memory"); __builtin_amdgcn_sched_barrier(0);
        }
    }
};

__device__ __forceinline__ void bc_stage_half(LAS unsigned char* lds, int ldsoff, const char* gbase, int rs, int tid, int wid) {
#pragma unroll
    for (int i = 0; i < 2; ++i) { int R, C; pg8::stage_rc(tid * 16 + i * 8192, R, C);
        __builtin_amdgcn_global_load_lds((const unsigned*)(gbase + (size_t)R * rs + C * 2), (LAS unsigned*)(lds + ldsoff + wid * 1024 + i * 8192), 16, 0, 0); }
}
__device__ __forceinline__ void p_fftBC(Frame& F) {
    using pg8::f16x8; using pg8::bf16x8;
    LAS unsigned char* lds = F.lds + RING_OFF;
    const int tid = F.tid, wid = F.wave;
    const int rh = wid >> 2, rb = (wid * 32) & 127;
    const char* FCT = (const char*)(F.ws + WS_FCT);
    constexpr int GR = 0, XO = 32768, FB = 98304;
#define BC_WAITV(n) asm volatile("s_waitcnt vmcnt(" #n ")" ::: "memory")
#define BC_BAR() do { asm volatile("s_waitcnt lgkmcnt(0)" ::: "memory"); __builtin_amdgcn_s_barrier(); asm volatile("" ::: "memory"); } while (0)
    unsigned fsrc[2];
#pragma unroll
    for (int i = 0; i < 2; ++i) { const int B = wid * 1024 + i * 8192 + (tid & 63) * 16, row = B >> 6, ch = ((B >> 4) & 3) ^ ((row >> 2) & 3); fsrc[i] = (unsigned)(row * 1024 + ch * 16); }
#define BC_STAGE_F(kt) do { _Pragma("unroll") for (int _i = 0; _i < 2; ++_i) \
        __builtin_amdgcn_global_load_lds((const unsigned*)(FCT + fsrc[_i] + (kt) * 64), (LAS unsigned*)(lds + FB + ((kt) % 3) * 16384 + wid * 1024 + _i * 8192), 16, 0, 0); } while (0)
#define BC_STAGE_BP(bpp) do { _Pragma("unroll") for (int r2 = 0; r2 < 2; ++r2) _Pragma("unroll") for (int kh = 0; kh < 2; ++kh) \
        bc_stage_half(lds, XO + (r2 * 2 + kh) * 16384, (bpp) + (size_t)r2 * 128 * 256 + kh * 128, 256, tid, wid); } while (0)
    int it = F.vcu;
    if (it >= BATCH * 128 * 8) return;
    {
        const char* G = (const char*)(F.ws + WS_G64);
#pragma unroll
        for (int kh = 0; kh < 2; ++kh) bc_stage_half(lds, GR + kh * 16384, G + kh * 128, 256, tid, wid);
        const int b = it >> 10, k1 = (it >> 3) & 127, g = it & 7;
        BC_STAGE_BP((const char*)(bp_ptr(F, b) + ((size_t)k1 * E + g * 256) * 128));
    }
#pragma unroll 1
    for (; it < BATCH * 128 * 8; it += F.G) {
        const int b = it >> 10, k1 = (it >> 3) & 127, g = it & 7;
        int lane = F.lane; asm volatile("" : "+v"(lane));
        const int fr = lane & 15, fq = lane >> 4;
        BC_WAITV(0); BC_BAR();
        BC_STAGE_F(0); BC_STAGE_F(1);
        f32x4 accB[2][8];
#pragma unroll
        for (int mt = 0; mt < 2; ++mt)
#pragma unroll
            for (int nt = 0; nt < 8; ++nt) accB[mt][nt] = (f32x4){0.f, 0.f, 0.f, 0.f};
#pragma unroll
        for (int kh = 0; kh < 2; ++kh)
#pragma unroll
            for (int kk = 0; kk < 2; ++kk) {
                bf16x8 a[2], bb[8];
#pragma unroll
                for (int mt = 0; mt < 2; ++mt) a[mt] = *(const LAS bf16x8*)(lds + XO + (rh * 2 + kh) * 16384 + pg8::lds_byte(rb + 16 * mt + fr, kk * 32 + fq * 8));
#pragma unroll
                for (int nt = 0; nt < 8; ++nt) bb[nt] = *(const LAS bf16x8*)(lds + GR + kh * 16384 + pg8::lds_byte(16 * nt + fr, kk * 32 + fq * 8));
                __builtin_amdgcn_sched_barrier(0);
#pragma unroll
                for (int nt = 0; nt < 8; ++nt)
#pragma unroll
                    for (int mt = 0; mt < 2; ++mt) accB[mt][nt] = __builtin_amdgcn_mfma_f32_16x16x32_f16(__builtin_bit_cast(f16x8, a[mt]), __builtin_bit_cast(f16x8, bb[nt]), accB[mt][nt], 0, 0, 0);
                __builtin_amdgcn_sched_barrier(0);
            }
        v2u zz[2][4];
#pragma unroll
        for (int mt = 0; mt < 2; ++mt)
#pragma unroll
            for (int nt = 0; nt < 4; ++nt) { const int m = wid * 32 + 16 * mt + 4 * fq, k2 = 16 * nt + fr;
                zz[mt][nt] = *(const GAS v2u*)((const h16*)(F.ws + WS_Q) + ((size_t)(b * T + k1 + 128 * k2) * E + g * 256 + m)); }
        BC_BAR();
#pragma unroll
        for (int mt = 0; mt < 2; ++mt)
#pragma unroll
            for (int nt = 0; nt < 8; ++nt) { const int ch = wid * 32 + 16 * mt + 4 * fq, ri = nt >> 2, k2 = (16 * nt + fr) & 63, kb = ri * 4 + (ch >> 6);
                v2u w; w.x = pk2h(accB[mt][nt][0], accB[mt][nt][1]); w.y = pk2h(accB[mt][nt][2], accB[mt][nt][3]);
                *(LAS v2u*)(lds + XO + kb * 8192 + pg8::lds_byte(k2, ch & 63)) = w; }
        f32x4 accC[2][4];
#pragma unroll
        for (int mt = 0; mt < 2; ++mt)
#pragma unroll
            for (int nt = 0; nt < 4; ++nt) accC[mt][nt] = (f32x4){0.f, 0.f, 0.f, 0.f};
#pragma unroll
        for (int kt = 0; kt < 16; ++kt) {
            if (kt < 15) BC_WAITV(2); else BC_WAITV(0);
            BC_BAR();
            if (kt + 2 < 16) BC_STAGE_F(kt + 2);
            bf16x8 a[2], bb[4];
#pragma unroll
            for (int mt = 0; mt < 2; ++mt) { const int row = wid * 32 + 16 * mt + fr; a[mt] = *(const LAS bf16x8*)(lds + FB + (kt % 3) * 16384 + row * 64 + 16 * (fq ^ ((row >> 2) & 3))); }
#pragma unroll
            for (int nt = 0; nt < 4; ++nt) bb[nt] = *(const LAS bf16x8*)(lds + XO + (kt >> 1) * 8192 + pg8::lds_byte(16 * nt + fr, (kt & 1) * 32 + fq * 8));
            __builtin_amdgcn_sched_barrier(0);
#pragma unroll
            for (int nt = 0; nt < 4; ++nt)
#pragma unroll
                for (int mt = 0; mt < 2; ++mt) accC[mt][nt] = __builtin_amdgcn_mfma_f32_16x16x32_f16(__builtin_bit_cast(f16x8, a[mt]), __builtin_bit_cast(f16x8, bb[nt]), accC[mt][nt], 0, 0, 0);
            __builtin_amdgcn_sched_barrier(0);
        }
        v2u wout[2][4];
#pragma unroll
        for (int mt = 0; mt < 2; ++mt)
#pragma unroll
            for (int nt = 0; nt < 4; ++nt) { const v2u zv = zz[mt][nt];
                wout[mt][nt].x = pk2h(accC[mt][nt][0] * h2f((h16)(zv.x & 0xffff)), accC[mt][nt][1] * h2f((h16)(zv.x >> 16)));
                wout[mt][nt].y = pk2h(accC[mt][nt][2] * h2f((h16)(zv.y & 0xffff)), accC[mt][nt][3] * h2f((h16)(zv.y >> 16))); }
        BC_BAR();
        if (it + F.G < BATCH * 128 * 8) { const int it2 = it + F.G, b2 = it2 >> 10, k12 = (it2 >> 3) & 127, g2 = it2 & 7;
            BC_STAGE_BP((const char*)(bp_ptr(F, b2) + ((size_t)k12 * E + g2 * 256) * 128)); }
#pragma unroll
        for (int mt = 0; mt < 2; ++mt)
#pragma unroll
            for (int nt = 0; nt < 4; ++nt) { const int m = wid * 32 + 16 * mt + 4 * fq, k2 = 16 * nt + fr;
                *(GAS v2u*)((h16*)(F.ws + WS_Y1) + ((size_t)(b * T + k1 + 128 * k2) * E + g * 256 + m)) = wout[mt][nt]; }
    }
    BC_WAITV(0); BC_BAR();
#undef BC_WAITV
#undef BC_BAR
#undef BC_STAGE_F
#undef BC_STAGE_BP
}

struct Args { const float* in[14]; float* out; unsigned char* ws; int ph_lo, ph_hi, li, pad; };
__global__ void __launch_bounds__(NWAVES * 64, 2) skel_fwd(Args args) {
    extern __shared__ __attribute__((aligned(16))) unsigned char lds[];
    Frame F;
    F.lds = (LAS unsigned char*)lds;
    F.MISC = (volatile LAS unsigned*)(F.lds + MISC_OFF);
    const int wave_s = __builtin_amdgcn_readfirstlane((int)threadIdx.x >> 6);
    F.tid = threadIdx.x; F.lane = F.tid & 63; F.wave = wave_s;
    F.G = gridDim.x; { const int bx = blockIdx.x; F.vcu = (F.G % 8 == 0) ? (bx % 8) * (F.G / 8) + bx / 8 : bx; }
    F.ws = args.ws; F.o = (unsigned char*)args.out;
    F.ctl = (gu32*)(F.ws + WS_CTL);
    F.x = args.in[0]; F.c = args.in[1]; F.ctx = args.in[2]; F.c_ctx = args.in[3]; F.ada_w = args.in[4]; F.ada_b = args.in[5]; F.norm_g = args.in[6];
    F.hg_w_in = args.in[7]; F.hg_lb = args.in[8]; F.hg_ng = args.in[9]; F.hg_w_out = args.in[10]; F.ft_w_in = args.in[11]; F.ft_w_out = args.in[12]; F.final_g = args.in[13];
    if (F.tid < 32) ((LAS unsigned*)(F.lds + MISC_OFF))[F.tid] = 0u;
    __syncthreads();
    XcdBarrier bar; bar.bar = (unsigned*)(F.ctl + CW_BAR); bar.x = 0; bar.st = nullptr;
    if (MK_N_LAUNCHES == 1) bar = xcd_barrier_post((unsigned*)(F.ctl + CW_BAR), F.MISC + 8);
#define GRID_BAR() do { if (MK_N_LAUNCHES == 1) { xcd_barrier(bar); if ((PROBE_MASK >> 14) & 1) xcd_barrier(bar); } } while (0)
    const int lo = args.ph_lo, hi = args.ph_hi;
#define IN(k) (lo <= (k) && (k) < hi)
#define MYTID() (wave_s * 64 + my_lane())
#define REFRESH() do { int t_ = MYTID(); asm volatile("" : "+v"(t_)); F.tid = t_; F.lane = t_ & 63; F.wave = wave_s; } while (0)
#define BOTH(k) (IN(k) && IN((k) + 1))
    const float* mod = (const float*)(F.ws + WS_MOD);

    if (IN(0)) { for (int rep = 0; rep < 1 + ((PROBE_MASK >> 0) & 1); ++rep) { REFRESH(); p0_prologue(F); } if (BOTH(0)) GRID_BAR(); }
    if (IN(1)) { for (int rep = 0; rep < 1 + ((PROBE_MASK >> 1) & 1); ++rep) { REFRESH(); p_norm0(F); } if (BOTH(1)) GRID_BAR(); }
#pragma unroll 1
    for (int half = 0; half < 2; ++half) {
        if (IN(2 + 2 * half)) for (int rep = 0; rep < 1 + ((PROBE_MASK >> 2) & 1); ++rep) {
            pg8::Gemm g = pg8::make_gemm(F.ws + WS_H0C, F.ws + WS_WIN + (size_t)half * NINH * D * 2, M + MC, NINH, D);
            pg8::StaticOrder S; S.init(M + MC, NINH, F.G, (int)blockIdx.x);
            EpiInProj0 Ep{F.ws, F.o, (const float*)(F.ws + WS_LB), half};
            pg8::gemm_phase<EpiInProj0, pg8::StaticOrder, true, true>(F.lds + RING_OFF, g, S, Ep, MYTID());
            if (rep == ((PROBE_MASK >> 2) & 1) && BOTH(2 + 2 * half)) GRID_BAR();
        }
        if (IN(3 + 2 * half)) {
            REFRESH();
#if SIMPLE_SCAN
            p_scan_simple(F, half);
#else
            for (int rep = 0; rep < 1 + ((PROBE_MASK >> 13) & 1); ++rep) { REFRESH(); p_scan1(F, half); } GRID_BAR(); REFRESH(); p_scan_combine(F); GRID_BAR(); if ((PROBE_MASK >> 15) & 1) { REFRESH(); p_scan2(F, half, true); } REFRESH(); p_scan2(F, half);
#endif
            if (BOTH(3 + 2 * half)) GRID_BAR();
        }
    }
    if (IN(6)) for (int rep = 0; rep < 1 + ((PROBE_MASK >> 6) & 1); ++rep) {
        pg8::Gemm g = pg8::make_gemm(F.ws + WS_Q, F.ws + WS_WOUT, M, D, E);
        g.a_rs = HD * 2; g.a_k1 = 128; g.a_k2 = (long)T * HD * 2; g.a_tdiv = T / 256; g.a_thi = (long)NH * T * HD * 2; g.a_tlo = 256L * HD * 2;
        pg8::StaticOrder S; S.init(M, D, F.G, (int)blockIdx.x);
        EpiOut0 Ep{F.ws, mod};
        pg8::gemm_phase<EpiOut0, pg8::StaticOrder, true, true>(F.lds + RING_OFF, g, S, Ep, MYTID());
        if (rep == ((PROBE_MASK >> 6) & 1) && BOTH(6)) GRID_BAR();
    }
    if (IN(7)) { for (int rep = 0; rep < 1 + ((PROBE_MASK >> 7) & 1); ++rep) { REFRESH(); p_norm1(F); } if (BOTH(7)) GRID_BAR(); }
    if (IN(8)) for (int rep = 0; rep < 1 + ((PROBE_MASK >> 8) & 1); ++rep) {
        { pg8::Gemm g = pg8::make_gemm(F.o + O_FTIN, F.ws + WS_H1P, E, M, D);
          pg8::StaticOrder S; S.init(E, M, F.G, (int)blockIdx.x);
          EpiU Ep{F.ws};
          pg8::gemm_phase<EpiU, pg8::StaticOrder, true, true>(F.lds + RING_OFF, g, S, Ep, MYTID()); }
        __syncthreads();
        { pg8::Gemm g = pg8::make_gemm(F.ws + WS_H1P, F.o + O_FTIN + (size_t)E * D * 2, M, E, D);
          pg8::StaticOrder S; S.init(M, E, F.G, (int)blockIdx.x);
          EpiZ Ep{F.ws};
          pg8::gemm_phase<EpiZ, pg8::StaticOrder, true, true>(F.lds + RING_OFF, g, S, Ep, MYTID()); }
        if (rep == ((PROBE_MASK >> 8) & 1) && BOTH(8)) GRID_BAR();
    }
    if (IN(9)) for (int rep = 0; rep < 1 + ((PROBE_MASK >> 9) & 1); ++rep) {
#if SIMPLE_FFTA
        REFRESH(); p_fftA_simple(F);
#else
        int kfa = 128; asm volatile("" : "+s"(kfa));
        pg8::Gemm g = pg8::make_gemm(F.ws + WS_F128, F.ws + WS_UT, 256, BATCH * E * 64, kfa);
        pg8::StaticOrder S; S.init(256, BATCH * E * 64, F.G, (int)blockIdx.x);
        EpiFftA Ep{F.ws, F.o};
        pg8::gemm_phase<EpiFftA, pg8::StaticOrder, true, true>(F.lds + RING_OFF, g, S, Ep, MYTID());
#endif
        if (rep == ((PROBE_MASK >> 9) & 1) && BOTH(9)) GRID_BAR();
    }
    if (IN(10)) for (int rep = 0; rep < 1 + ((PROBE_MASK >> 10) & 1); ++rep) {
        REFRESH();
#if SIMPLE_FFTBC
        p_fftBC_simple(F);
#else
        p_fftBC(F);
#endif
        if (rep == ((PROBE_MASK >> 10) & 1) && BOTH(10)) GRID_BAR();
    }
    if (IN(11)) for (int rep = 0; rep < 1 + ((PROBE_MASK >> 11) & 1); ++rep) {
        pg8::Gemm g = pg8::make_gemm(F.ws + WS_Y1, F.ws + WS_FTOUT, M, D, E);
        pg8::StaticOrder S; S.init(M, D, F.G, (int)blockIdx.x);
        EpiOut1 Ep{F.o, mod};
        pg8::gemm_phase<EpiOut1, pg8::StaticOrder, true, true>(F.lds + RING_OFF, g, S, Ep, MYTID());
        if (rep == ((PROBE_MASK >> 11) & 1) && BOTH(11)) GRID_BAR();
    }
    if (IN(12)) { REFRESH(); p_final(F); }
#undef IN
#undef BOTH
}

extern "C" void kernel_launch(void* const* d_in, const int* in_sizes, int n_in, void* d_out, int out_size, void* d_ws, size_t ws_size, hipStream_t stream) {
    static int grid = 0;
    if (grid == 0) {
        if (n_in != 14 || in_sizes[0] != M * D || out_size != M * D || ws_size < WS_END) { fprintf(stderr, "kernel_launch: unexpected shapes (n_in %d, ws %zu)\n", n_in, ws_size); grid = -1; return; }
        int dev = 0, cus = 0, per_cu = 0;
        if (hipGetDevice(&dev) != hipSuccess || hipDeviceGetAttribute(&cus, hipDeviceAttributeMultiprocessorCount, dev) != hipSuccess) { grid = -1; return; }
        if (hipFuncSetAttribute((const void*)skel_fwd, hipFuncAttributeMaxDynamicSharedMemorySize, LDS_BYTES) != hipSuccess) { fprintf(stderr, "kernel_launch: hipFuncSetAttribute failed\n"); grid = -1; return; }
        if (hipOccupancyMaxActiveBlocksPerMultiprocessor(&per_cu, (const void*)skel_fwd, NWAVES * 64, LDS_BYTES) != hipSuccess || per_cu < 1) { fprintf(stderr, "kernel_launch: occupancy query says %d\n", per_cu); per_cu = 1; }
        (void)hipGetLastError();
        grid = cus;
    }
    if (grid < 0) return;
    (void)hipMemsetAsync((char*)d_ws + WS_CTL, 0, CTL_ZERO_BYTES, stream);
    Args a{};
    for (int i = 0; i < 14; ++i) a.in[i] = (const float*)d_in[i];
    a.out = (float*)d_out; a.ws = (unsigned char*)d_ws;
    if (MK_N_LAUNCHES == 1) { a.ph_lo = 0; a.ph_hi = N_PHASES; a.li = 0; hipLaunchKernelGGL(skel_fwd, dim3(grid), dim3(NWAVES * 64), LDS_BYTES, stream, a); }
    else for (int li = 0; li < N_PHASES; ++li) { a.ph_lo = li; a.ph_hi = li + 1; a.li = li; hipLaunchKernelGGL(skel_fwd, dim3(grid), dim3(NWAVES * 64), LDS_BYTES, stream, a); }
}
```
